# Optimizing an MI355X kernel written in HIP

```python
import math
import jax, jax.numpy as jnp
from jax import lax
import numpy as np

D_MODEL = 1024
BATCH = 1
SEQ = 16384
DEPTH = 1

CHUNK = 64
Q_BLOCK = 128
D_MIX = D_MODEL
DIFF_HEADS = 4
DIFF_QK_DIM = 64
DIFF_V_DIM = 2 * DIFF_QK_DIM
DIFF_WIDTH = DIFF_HEADS * DIFF_V_DIM
MLA_HEADS = 4
MLA_Q_RANK = 256
MLA_KV_RANK = 128
MLA_NOPE_DIM = 128
MLA_ROPE_DIM = 64
MLA_QK_DIM = MLA_NOPE_DIM + MLA_ROPE_DIM
MLA_V_DIM = 128
MLA_WIDTH = MLA_HEADS * MLA_V_DIM
ROPE_THETA = 10000.0
REL_BUCKETS = 32
REL_MAX_DIST = 128
RMS_EPS = 1e-6
NEG_INF = -1e30
COL_DIFF_Q = DIFF_HEADS * 2 * DIFF_QK_DIM
COL_DIFF_K = DIFF_HEADS * 2 * DIFF_QK_DIM
COL_DIFF_V = DIFF_WIDTH
COL_MLA_CQ = MLA_Q_RANK
COL_MLA_CKV = MLA_KV_RANK
COL_MLA_KR = MLA_ROPE_DIM
COL_GATE = D_MIX
IN_COLS = COL_DIFF_Q + COL_DIFF_K + COL_DIFF_V + COL_MLA_CQ + COL_MLA_CKV + COL_MLA_KR + COL_GATE

kernel_name = "hybrid_diffattn_mla_parallel_heads"


def _rms_norm(x, g):
    xf = x.astype(jnp.float32)
    y = xf * lax.rsqrt(jnp.mean(xf * xf, axis=-1, keepdims=True) + RMS_EPS)
    return (y * g.astype(jnp.float32)).astype(x.dtype)


def _rope(x, cos, sin):
    x1, x2 = jnp.split(x, 2, axis=-1)
    return jnp.concatenate([x1 * cos - x2 * sin, x2 * cos + x1 * sin], axis=-1).astype(x.dtype)


def _t5_bucket(rel):
    nb = REL_BUCKETS // 2
    max_exact = nb // 2
    ret = jnp.where(rel > 0, nb, 0)
    n = jnp.abs(rel)
    nf = jnp.maximum(n, 1).astype(jnp.float32)
    large = max_exact + (jnp.log(nf / max_exact) / math.log(REL_MAX_DIST / max_exact)
                         * (nb - max_exact)).astype(jnp.int32)
    large = jnp.minimum(large, nb - 1)
    return ret + jnp.where(n < max_exact, n, large)


def setup_inputs(seed: int = 0) -> dict:
    key = jax.random.key(seed)
    ks = jax.random.split(key, 24)
    f32 = jnp.float32
    nrm = lambda k, shape, s: jax.random.normal(k, shape, f32) * s
    gain = lambda k, shape: 1.0 + 0.1 * jax.random.normal(k, shape, f32)
    x = jax.random.normal(ks[0], (BATCH, SEQ, D_MODEL), f32)
    c = jax.random.normal(ks[1], (BATCH, D_MODEL), f32)
    offset = jax.random.randint(ks[2], (BATCH, 1), 0, 1024, dtype=jnp.int32) * CHUNK
    positions = (offset + jnp.arange(SEQ, dtype=jnp.int32)[None, :]).astype(jnp.int32)
    return {
        "x": x,
        "c": c,
        "positions": positions,
        "rel_bias": nrm(ks[3], (REL_BUCKETS, DIFF_HEADS), 0.5),
        "ada_w": nrm(ks[4], (DEPTH, D_MODEL, 3 * D_MODEL), 0.5 * D_MODEL ** -0.5),
        "ada_b": nrm(ks[5], (DEPTH, 3 * D_MODEL), 0.02),
        "norm_g": gain(ks[6], (DEPTH, D_MODEL)),
        "w_in": nrm(ks[7], (DEPTH, D_MODEL, IN_COLS), D_MODEL ** -0.5),
        "diff_q_norm": gain(ks[8], (DEPTH, DIFF_QK_DIM)),
        "diff_k_norm": gain(ks[9], (DEPTH, DIFF_QK_DIM)),
        "diff_lambda": nrm(ks[10], (DEPTH, 4, DIFF_QK_DIM), 0.1),
        "diff_sub_norm": gain(ks[11], (DEPTH, DIFF_V_DIM)),
        "mla_q_a_norm": gain(ks[12], (DEPTH, MLA_Q_RANK)),
        "mla_kv_a_norm": gain(ks[13], (DEPTH, MLA_KV_RANK)),
        "w_uq": nrm(ks[14], (DEPTH, MLA_Q_RANK, MLA_HEADS * MLA_QK_DIM), MLA_Q_RANK ** -0.5),
        "w_uk": nrm(ks[15], (DEPTH, MLA_KV_RANK, MLA_HEADS * MLA_NOPE_DIM), MLA_KV_RANK ** -0.5),
        "w_uv": nrm(ks[16], (DEPTH, MLA_KV_RANK, MLA_HEADS * MLA_V_DIM), MLA_KV_RANK ** -0.5),
        "mla_q_norm": gain(ks[17], (DEPTH, MLA_QK_DIM)),
        "mla_k_norm": gain(ks[18], (DEPTH, MLA_QK_DIM)),
        "w_out": nrm(ks[19], (DEPTH, D_MIX, D_MODEL), D_MIX ** -0.5),
    }


def _layer(x, c, positions, rel_bias, layer_idx, ada_w, ada_b, norm_g, w_in,
           diff_q_norm, diff_k_norm, diff_lambda, diff_sub_norm,
           mla_q_a_norm, mla_kv_a_norm, w_uq, w_uk, w_uv, mla_q_norm, mla_k_norm, w_out):
    B, S, _ = x.shape
    mod = jax.nn.silu(c) @ ada_w + ada_b
    shift, scale, gate = jnp.split(mod, 3, axis=-1)
    h = _rms_norm(x, norm_g) * (1.0 + scale[:, None, :]) + shift[:, None, :]

    proj = h @ w_in
    cuts = np.cumsum([COL_DIFF_Q, COL_DIFF_K, COL_DIFF_V, COL_MLA_CQ, COL_MLA_CKV, COL_MLA_KR])
    dq, dk, dv, cq, ckv, kr, g = jnp.split(proj, [int(v) for v in cuts], axis=-1)

    dq = _rms_norm(dq.reshape(B, S, DIFF_HEADS, 2, DIFF_QK_DIM), diff_q_norm)
    dk = _rms_norm(dk.reshape(B, S, DIFF_HEADS, 2, DIFF_QK_DIM), diff_k_norm)
    dv = dv.reshape(B, S, DIFF_HEADS, DIFF_V_DIM)
    lam_init = 0.8 - 0.6 * math.exp(-0.3 * (layer_idx - 1))
    lam_f = diff_lambda.astype(jnp.float32)
    lam = (jnp.exp(jnp.sum(lam_f[0] * lam_f[1])) - jnp.exp(jnp.sum(lam_f[2] * lam_f[3]))
           + lam_init)

    half = MLA_ROPE_DIM // 2
    inv_freq = ROPE_THETA ** (-jnp.arange(half, dtype=jnp.float32) / half)
    ang = positions.astype(jnp.float32)[:, :, None] * inv_freq
    cos, sin = jnp.cos(ang), jnp.sin(ang)
    q_m = (_rms_norm(cq, mla_q_a_norm) @ w_uq).reshape(B, S, MLA_HEADS, MLA_QK_DIM)
    q_nope, q_pe = q_m[..., :MLA_NOPE_DIM], q_m[..., MLA_NOPE_DIM:]
    q_pe = _rope(q_pe, cos[:, :, None, :], sin[:, :, None, :])
    ckv_n = _rms_norm(ckv, mla_kv_a_norm)
    k_nope = (ckv_n @ w_uk).reshape(B, S, MLA_HEADS, MLA_NOPE_DIM)
    v_m = (ckv_n @ w_uv).reshape(B, S, MLA_HEADS, MLA_V_DIM)
    k_pe = jnp.broadcast_to(_rope(kr, cos, sin)[:, :, None, :], (B, S, MLA_HEADS, MLA_ROPE_DIM))
    q_m = _rms_norm(jnp.concatenate([q_nope, q_pe], axis=-1), mla_q_norm)
    k_m = _rms_norm(jnp.concatenate([k_nope, k_pe], axis=-1), mla_k_norm)

    key_chunk = positions // CHUNK
    diff_scale = DIFF_QK_DIM ** -0.5
    mla_scale = MLA_QK_DIM ** -0.5

    def attend_block(i):
        q0 = i * Q_BLOCK
        qpos = lax.dynamic_slice_in_dim(positions, q0, Q_BLOCK, axis=1)
        allowed = key_chunk[:, None, :] <= (qpos // CHUNK)[:, :, None]
        bucket = _t5_bucket(positions[:, None, :] - qpos[:, :, None])
        bias = jnp.transpose(rel_bias[bucket], (0, 3, 1, 2)).astype(jnp.float32)
        dq_b = lax.dynamic_slice_in_dim(dq, q0, Q_BLOCK, axis=1)
        logit_d = jnp.einsum('bqhcd,bkhcd->bchqk', dq_b, dk).astype(jnp.float32) * diff_scale
        logit_d = jnp.where(allowed[:, None, None], logit_d + bias[:, None], NEG_INF)
        p_d = jax.nn.softmax(logit_d, axis=-1)
        attn_d = p_d[:, 0] - lam * p_d[:, 1]
        o_d = jnp.einsum('bhqk,bkhd->bqhd', attn_d.astype(dv.dtype), dv)
        o_d = _rms_norm(o_d, diff_sub_norm) * (1.0 - lam_init)
        q_b = lax.dynamic_slice_in_dim(q_m, q0, Q_BLOCK, axis=1)
        logit_m = jnp.einsum('bqhd,bkhd->bhqk', q_b, k_m).astype(jnp.float32) * mla_scale
        logit_m = jnp.where(allowed[:, None], logit_m, NEG_INF)
        p_m = jax.nn.softmax(logit_m, axis=-1)
        o_m = jnp.einsum('bhqk,bkhd->bqhd', p_m.astype(v_m.dtype), v_m)
        return jnp.concatenate([o_d.reshape(B, Q_BLOCK, DIFF_WIDTH),
                                o_m.reshape(B, Q_BLOCK, MLA_WIDTH)], axis=-1)

    n_blocks = S // Q_BLOCK
    mixed = lax.map(attend_block, jnp.arange(n_blocks, dtype=jnp.int32))
    mixed = jnp.transpose(mixed, (1, 0, 2, 3)).reshape(B, S, D_MIX)
    out = (mixed * jax.nn.silu(g)) @ w_out
    return x + gate[:, None, :] * out


def reference(x, c, positions, rel_bias, ada_w, ada_b, norm_g, w_in, diff_q_norm, diff_k_norm,
              diff_lambda, diff_sub_norm, mla_q_a_norm, mla_kv_a_norm, w_uq, w_uk, w_uv,
              mla_q_norm, mla_k_norm, w_out):
    for l in range(DEPTH):
        x = _layer(x, c, positions, rel_bias, l + 1, ada_w[l], ada_b[l], norm_g[l], w_in[l],
                   diff_q_norm[l], diff_k_norm[l], diff_lambda[l], diff_sub_norm[l],
                   mla_q_a_norm[l], mla_kv_a_norm[l], w_uq[l], w_uk[l], w_uv[l],
                   mla_q_norm[l], mla_k_norm[l], w_out[l])
    return x
```

```cpp
#include <hip/hip_runtime.h>
#include <hip/hip_bf16.h>
#include <cstdio>
#include <cstdint>
namespace pg8 {
#define PG8_LAS __attribute__((address_space(3)))
typedef unsigned short bf16_t;
typedef short bf16x8 __attribute__((ext_vector_type(8)));
typedef float f32x4 __attribute__((ext_vector_type(4)));
typedef unsigned u32x4 __attribute__((ext_vector_type(4)));
constexpr int BM = 256, BK = 64, HALF = 128, HTB = HALF * BK * 2  , STAGE_BYTES = 8 * HTB, NXCD = 8, WGM = 8;

__host__ __device__ __forceinline__ int lds_byte(int r, int c) { const int st = (r >> 4) * 2 + (c >> 5), rr = r & 15, cc = c & 31, ob = rr * 64 + cc * 2; return st * 1024 + (ob ^ (((ob >> 9) & 1) << 5)); }
__host__ __device__ __forceinline__ void stage_rc(int b, int& R, int& C) { const int st = b / 1024, sb = b % 1024, swz = sb ^ (((sb >> 9) & 1) << 5); R = (st >> 1) * 16 + swz / 64; C = (st & 1) * 32 + (swz % 64) / 2; }
__host__ __device__ __forceinline__ int perm32(int rho) { const int n = rho >> 4, i = rho & 15; return 8 * (i >> 2) + 4 * n + (i & 3); }

struct Unit { int pm, pn; };
struct Gemm { const bf16_t* A; const bf16_t* Bt; int M, N, K; };

struct StaticOrder {
    int nM, nN, nwg, G, c;
    __host__ __device__ void init(int M, int N, int G_, int c_) { nM = M / BM; nN = N / BM; nwg = nM * nN; G = G_; c = c_; }
    __host__ __device__ bool next(int i, Unit& u) const {
        const long L = (long)i * G + c; if (L >= nwg) return false;
        int wgid = (int)L; { const int q = nwg / NXCD, r = nwg % NXCD, xcd = wgid % NXCD, off = wgid / NXCD; wgid = (xcd < r ? xcd * (q + 1) : r * (q + 1) + (xcd - r) * q) + off; }
        const int nig = WGM * nN, gid = wgid / nig, fm = gid * WGM, gsz = (nM - fm) < WGM ? (nM - fm) : WGM;
        u.pm = fm + ((wgid % nig) % gsz); u.pn = (wgid % nig) / gsz; return true;
    }
    __device__ __forceinline__ void a_ready(const Unit&) const {}
    __device__ __forceinline__ void done(const Unit&) const {}
};
__device__ __forceinline__ unsigned cvt_pk_bf16(float lo, float hi) { unsigned r; asm volatile("v_cvt_pk_bf16_f32 %0, %1, %2" : "=v"(r) : "v"(lo), "v"(hi)); return r; }
typedef float f32x2 __attribute__((ext_vector_type(2)));
template <class Epi, class Sched, bool ALIGN_EPI = false, bool SP2 = false>
__device__ __forceinline__ void gemm_phase(PG8_LAS unsigned char* lds, const Gemm g, const Sched& S, const Epi& E) {
    const int tid = threadIdx.x, wid = __builtin_amdgcn_readfirstlane(tid >> 6), lane = tid & 63, wr = wid >> 2, wc = wid & 3, fr = lane & 15, fq = lane >> 4;
    const int K = g.K, nt = K / BK;
    unsigned voffA[2], voffB[2];
#pragma unroll
    for (int i = 0; i < 2; ++i) { int R, C; stage_rc(tid * 16 + i * 8192, R, C); const int Rb = Epi::PERM ? ((R & ~31) + perm32(R & 31)) : R;
        voffA[i] = (unsigned)(R * K + C) * 2u; voffB[i] = (unsigned)(Rb * K + C) * 2u; }
    const size_t kstep = (size_t)(BK * 2);
    const size_t hstep = (size_t)HALF * K * 2;
    const size_t tstep = 2 * hstep;
    const unsigned ldsw = (unsigned)wid * 1024u;
    const int aoff = lds_byte(wr * 64 + fr, fq * 8), boff = lds_byte(wc * 32 + fr, fq * 8);
#define PG8_SA(b, h) (((b) * 2 + (h)) * HTB)
#define PG8_SB(b, h) ((4 + (b) * 2 + (h)) * HTB)
#define PG8_STAGE(bufoff, gbase, voff) do { _Pragma("unroll") for (int _i = 0; _i < 2; ++_i) \
        __builtin_amdgcn_global_load_lds((const unsigned*)((const char*)(gbase) + (voff)[_i]), (PG8_LAS unsigned*)(lds + (bufoff) + ldsw + _i * 8192), 16, 0, 0); } while (0)
#define PG8_LDA(dst, b, h) do { _Pragma("unroll") for (int m = 0; m < 4; ++m) _Pragma("unroll") for (int k = 0; k < 2; ++k) dst[m][k] = *(const PG8_LAS bf16x8*)(lds + PG8_SA(b, h) + aoff + m * 2048 + k * 1024); } while (0)
#define PG8_LDB(dst, b, h) do { _Pragma("unroll") for (int n = 0; n < 2; ++n) _Pragma("unroll") for (int k = 0; k < 2; ++k) dst[n][k] = *(const PG8_LAS bf16x8*)(lds + PG8_SB(b, h) + boff + n * 2048 + k * 1024); } while (0)
#define PG8_MMA(ai, bj, At, Bt) do { __builtin_amdgcn_s_setprio(1); _Pragma("unroll") for (int m = 0; m < 4; ++m) _Pragma("unroll") for (int n = 0; n < 2; ++n) _Pragma("unroll") for (int k = 0; k < 2; ++k) \
        acc[ai][bj][m][n] = __builtin_amdgcn_mfma_f32_16x16x32_bf16(Bt[n][k], At[m][k], acc[ai][bj][m][n], 0, 0, 0); __builtin_amdgcn_s_setprio(0); } while (0)
#define PG8_WAIT_V(n) asm volatile("s_waitcnt vmcnt(" #n ")" ::: "memory")
#define PG8_WAIT_L(n) asm volatile("s_waitcnt lgkmcnt(" #n ")" ::: "memory")
#define PG8_BAR __builtin_amdgcn_s_barrier()
#define PG8_SCHED __builtin_amdgcn_sched_barrier(0)
    Unit cur, nxt; int ui = 0;
    if (!S.next(0, cur)) return;
    f32x4 acc[2][2][4][2];
#pragma unroll
    for (int a = 0; a < 2; ++a)
#pragma unroll
        for (int b = 0; b < 2; ++b)
#pragma unroll
            for (int m = 0; m < 4; ++m)
#pragma unroll
                for (int n = 0; n < 2; ++n) acc[a][b][m][n] = (f32x4){0.f, 0.f, 0.f, 0.f};
    bf16x8 At[4][2], B0[2][2], B1[2][2];
    const char* cA = (const char*)g.A + (size_t)cur.pm * tstep; const char* cB = (const char*)g.Bt + (size_t)cur.pn * tstep;
    S.a_ready(cur);
    if constexpr (SP2) {
        PG8_STAGE(PG8_SB(0, 0), cB, voffB); PG8_STAGE(PG8_SB(0, 1), cB + hstep, voffB); PG8_STAGE(PG8_SA(0, 0), cA, voffA); PG8_STAGE(PG8_SA(0, 1), cA + hstep, voffA);
        if (wr == 1) PG8_BAR;
        PG8_WAIT_V(2); PG8_BAR;
        PG8_STAGE(PG8_SB(1, 0), cB + kstep, voffB); PG8_STAGE(PG8_SA(1, 0), cA + kstep, voffA); PG8_STAGE(PG8_SB(1, 1), cB + hstep + kstep, voffB);
        PG8_WAIT_V(6); PG8_BAR;
    } else {
        PG8_STAGE(PG8_SB(0, 0), cB, voffB); PG8_STAGE(PG8_SA(0, 0), cA, voffA); PG8_STAGE(PG8_SB(0, 1), cB + hstep, voffB); PG8_STAGE(PG8_SA(0, 1), cA + hstep, voffA);
        if (wr == 1) PG8_BAR;
        PG8_WAIT_V(4); PG8_BAR;
        PG8_STAGE(PG8_SB(1, 0), cB + kstep, voffB); PG8_STAGE(PG8_SA(1, 0), cA + kstep, voffA); PG8_STAGE(PG8_SB(1, 1), cB + hstep + kstep, voffB);
        PG8_WAIT_V(6); PG8_BAR;
    }
    for (;;) {
        const bool has_next = S.next(ui + 1, nxt);
        const char* nA = has_next ? (const char*)g.A + (size_t)nxt.pm * tstep : cA; const char* nB = has_next ? (const char*)g.Bt + (size_t)nxt.pn * tstep : cB;
        for (int t = 0; t < nt; t += 2) {
            const bool last = (t == nt - 2);
            const char* a1 = cA + (size_t)(t + 1) * kstep;
            const char* a2 = last ? nA : cA + (size_t)(t + 2) * kstep; const char* b2 = last ? nB : cB + (size_t)(t + 2) * kstep;
            const char* a3 = a2 + kstep; const char* b3 = b2 + kstep;
            if (last && has_next) S.a_ready(nxt);
            if constexpr (SP2) {
            PG8_LDB(B0, 0, 0); PG8_LDB(B1, 0, 1); PG8_SCHED; PG8_LDA(At, 0, 0); PG8_STAGE(PG8_SA(1, 1), a1 + hstep, voffA);
            PG8_WAIT_V(8); PG8_WAIT_L(0); PG8_BAR; PG8_MMA(0, 0, At, B0); PG8_MMA(0, 1, At, B1); PG8_BAR; PG8_SCHED;
            PG8_LDA(At, 0, 1); PG8_STAGE(PG8_SB(0, 0), b2, voffB); PG8_STAGE(PG8_SB(0, 1), b2 + hstep, voffB); PG8_STAGE(PG8_SA(0, 0), a2, voffA);
            PG8_WAIT_V(8); PG8_WAIT_L(0); PG8_BAR; PG8_MMA(1, 0, At, B0); PG8_MMA(1, 1, At, B1); PG8_BAR; PG8_SCHED;
            PG8_LDB(B0, 1, 0); PG8_LDB(B1, 1, 1); PG8_SCHED; PG8_LDA(At, 1, 0); PG8_STAGE(PG8_SA(0, 1), a2 + hstep, voffA);
            PG8_WAIT_V(8); PG8_WAIT_L(0); PG8_BAR; PG8_MMA(0, 0, At, B0); PG8_MMA(0, 1, At, B1); PG8_BAR; PG8_SCHED;
            PG8_LDA(At, 1, 1); PG8_STAGE(PG8_SB(1, 0), b3, voffB); PG8_STAGE(PG8_SB(1, 1), b3 + hstep, voffB); PG8_STAGE(PG8_SA(1, 0), a3, voffA);
            PG8_WAIT_V(8); PG8_WAIT_L(0); PG8_BAR; PG8_MMA(1, 0, At, B0); PG8_MMA(1, 1, At, B1); PG8_BAR; PG8_SCHED;
            } else {
            PG8_LDB(B0, 0, 0); PG8_SCHED; PG8_LDA(At, 0, 0); PG8_STAGE(PG8_SA(1, 1), a1 + hstep, voffA);
            PG8_WAIT_L(8); PG8_BAR; PG8_WAIT_L(0); PG8_MMA(0, 0, At, B0); PG8_BAR; PG8_SCHED;
            PG8_LDB(B1, 0, 1); PG8_STAGE(PG8_SB(0, 0), b2, voffB);
            PG8_BAR; PG8_WAIT_L(0); PG8_MMA(0, 1, At, B1); PG8_BAR;
            PG8_LDA(At, 0, 1); PG8_STAGE(PG8_SA(0, 0), a2, voffA);
            PG8_BAR; PG8_WAIT_L(0); PG8_MMA(1, 0, At, B0); PG8_BAR; PG8_SCHED;
            PG8_STAGE(PG8_SB(0, 1), b2 + hstep, voffB);
            PG8_WAIT_V(6); PG8_BAR; PG8_MMA(1, 1, At, B1); PG8_BAR;
            PG8_LDB(B0, 1, 0); PG8_SCHED; PG8_LDA(At, 1, 0); PG8_STAGE(PG8_SA(0, 1), a2 + hstep, voffA);
            PG8_WAIT_L(8); PG8_BAR; PG8_WAIT_L(0); PG8_MMA(0, 0, At, B0); PG8_BAR; PG8_SCHED;
            PG8_LDB(B1, 1, 1); PG8_STAGE(PG8_SB(1, 0), b3, voffB);
            PG8_BAR; PG8_WAIT_L(0); PG8_MMA(0, 1, At, B1); PG8_BAR;
            PG8_LDA(At, 1, 1); PG8_STAGE(PG8_SA(1, 0), a3, voffA);
            PG8_BAR; PG8_WAIT_L(0); PG8_MMA(1, 0, At, B0); PG8_BAR; PG8_SCHED;
            PG8_STAGE(PG8_SB(1, 1), b3 + hstep, voffB);
            PG8_WAIT_V(6); PG8_BAR; PG8_MMA(1, 1, At, B1); PG8_BAR;
            }
        }
        if constexpr (ALIGN_EPI) { if (wr == 0) PG8_BAR; }
        if constexpr (!Epi::AFTER_DRAIN) { E(acc, cur, wr, wc, fr, fq); S.done(cur); }
        if (!has_next) break;
#pragma unroll
        for (int a = 0; a < 2; ++a)
#pragma unroll
            for (int b = 0; b < 2; ++b)
#pragma unroll
                for (int m = 0; m < 4; ++m)
#pragma unroll
                    for (int n = 0; n < 2; ++n) acc[a][b][m][n] = (f32x4){0.f, 0.f, 0.f, 0.f};
        cur = nxt; cA = nA; cB = nB; ++ui;
        if constexpr (ALIGN_EPI) { if (wr == 1) PG8_BAR; }
    }
    PG8_WAIT_V(0);
    if constexpr (!ALIGN_EPI) { if (wr == 0) PG8_BAR; }
    PG8_BAR;
    if constexpr (Epi::AFTER_DRAIN) { E.fused(acc, cur, wr, wc, fr, fq, lds, wid, lane); S.done(cur); }
#undef PG8_SA
#undef PG8_SB
#undef PG8_STAGE
#undef PG8_LDA
#undef PG8_LDB
#undef PG8_MMA
#undef PG8_WAIT_V
#undef PG8_WAIT_L
#undef PG8_BAR
#undef PG8_SCHED
}
}
#define GAS __attribute__((address_space(1)))
#define LAS __attribute__((address_space(3)))
typedef unsigned short bf16;
typedef unsigned v4u __attribute__((ext_vector_type(4)));
typedef float f32x4 __attribute__((ext_vector_type(4)));
typedef short bf16x8 __attribute__((ext_vector_type(8)));
typedef GAS unsigned gu32;
typedef GAS unsigned long long gu64;
#define RLX_AGENT __ATOMIC_RELAXED, __HIP_MEMORY_SCOPE_AGENT
#define LDS_WAIT() asm volatile("s_waitcnt lgkmcnt(0)" ::: "memory")
#define VM_WAIT() asm volatile("s_waitcnt vmcnt(0)" ::: "memory")
__device__ __forceinline__ unsigned long long rt() { return __builtin_amdgcn_s_memrealtime(); }
__device__ __forceinline__ unsigned f2bf(float f) { unsigned u = __builtin_bit_cast(unsigned, f); return (u + 0x7fffu + ((u >> 16) & 1u)) >> 16; }
__device__ __forceinline__ unsigned pk2(float lo, float hi) { return f2bf(lo) | (f2bf(hi) << 16); }

#define XB_TMO      128
#define XB_XCNT(j)  (256  + 64 * (j))
#define XB_XSUB(j)  (1280 + 64 * (j))
#define XB_XGEN(j)  (2304 + 64 * (j))
#define XB_TOP      3328
#define XB_TOPGEN   3392
#define XCD_BAR_WORDS 3456
#define XB_SPIN_CAP (1u << 18)

__device__ __forceinline__ unsigned xb_ld(unsigned* p)              { return __hip_atomic_load(p, __ATOMIC_RELAXED, __HIP_MEMORY_SCOPE_AGENT); }
__device__ __forceinline__ unsigned xb_add(unsigned* p, unsigned v) { return __hip_atomic_fetch_add(p, v, __ATOMIC_RELAXED, __HIP_MEMORY_SCOPE_AGENT); }
__device__ __forceinline__ unsigned xb_xcc_id() { return (unsigned)__builtin_amdgcn_s_getreg((3 << 11) | 20) & 0xFu; }
#define XB_SPIN(cond, bar) do { unsigned _sp = 0; while (cond) { __builtin_amdgcn_s_sleep(1); \
    if ((++_sp & 255u) == 0u) { if (xb_ld(&(bar)[XB_TMO])) break; if (_sp > XB_SPIN_CAP) { atomicAdd(&(bar)[XB_TMO], 1u); break; } } } } while (0)

struct XcdBarrier {
    unsigned* bar; unsigned x;
    volatile LAS unsigned* st;
};

__device__ __forceinline__ XcdBarrier xcd_barrier_post(unsigned* bar, volatile LAS unsigned* st) {
    XcdBarrier b; b.bar = bar; b.x = xb_xcc_id(); b.st = st;
    if (threadIdx.x == 0) (void)xb_add(&bar[XB_XCNT(b.x)], 1u);
    return b;
}
__device__ __forceinline__ void xcd_barrier_complete(unsigned* bar, unsigned x, unsigned& nloc, unsigned& nx) {
    const unsigned G = gridDim.x * gridDim.y * gridDim.z;
    unsigned sum, cnt, mine, sp = 0u;
    for (;;) {
        sum = 0u; cnt = 0u; mine = 0u;
#pragma unroll
        for (unsigned j = 0; j < 16; ++j) { const unsigned c = xb_ld(&bar[XB_XCNT(j)]); sum += c; cnt += (c > 0u) ? 1u : 0u; mine = (j == x) ? c : mine; }
        if (sum == G) break;
        __builtin_amdgcn_s_sleep(1);
        if ((++sp & 255u) == 0u) { if (xb_ld(&bar[XB_TMO])) break; if (sp > XB_SPIN_CAP) { atomicAdd(&bar[XB_TMO], 1u); break; } }
    }
    nloc = mine > 0u ? mine : 1u; nx = cnt > 0u ? cnt : 1u;
}

__device__ __forceinline__ void xcd_barrier(const XcdBarrier& b) {
    asm volatile("s_waitcnt vmcnt(0)" ::: "memory");
    __syncthreads();
    if (threadIdx.x == 0) {
        unsigned* bar = b.bar;
        __builtin_amdgcn_s_waitcnt(0);
        unsigned nloc = b.st[0], nx = b.st[1];
        if (nloc == 0u) { xcd_barrier_complete(bar, b.x, nloc, nx); b.st[0] = nloc; b.st[1] = nx; }
        const unsigned old = xb_add(&bar[XB_XSUB(b.x)], 1u);
        const unsigned gen = old / nloc;
        if (old + 1u == (gen + 1u) * nloc) {
            __builtin_amdgcn_fence(__ATOMIC_RELEASE, "agent");
            asm volatile("s_waitcnt vmcnt(0)" ::: "memory");
            const unsigned og = xb_add(&bar[XB_TOP], 1u);
            const unsigned tg = og / nx;
            if (og + 1u == (tg + 1u) * nx) xb_add(&bar[XB_TOPGEN], 1u);
            else XB_SPIN(xb_ld(&bar[XB_TOPGEN]) == tg, bar);
            __builtin_amdgcn_fence(__ATOMIC_ACQUIRE, "agent");
            xb_add(&bar[XB_XGEN(b.x)], 1u);
            asm volatile("s_waitcnt vmcnt(0)" ::: "memory");
        } else {
            XB_SPIN(xb_ld(&bar[XB_XGEN(b.x)]) == gen, bar);
            __builtin_amdgcn_fence(__ATOMIC_ACQUIRE, "agent");
            asm volatile("s_waitcnt vmcnt(0)" ::: "memory");
        }
    }
    __syncthreads();
}
namespace mk {
constexpr int S = 16384, DM = 1024, NIN = 3008, NINP = 3072, NWAVES = 8;
constexpr float RMS_EPS = 1e-6f, LOG2E = 1.4426950408889634f;
constexpr float DIFF_C = 0.125f * LOG2E;
constexpr float MLA_C = 0.07216878364870323f * LOG2E;
constexpr size_t MiB = 1u << 20;
constexpr size_t WS_CTL = 0, CTL_ZERO_BYTES = 1 * MiB;
constexpr size_t WS_MODP = 1 * MiB;
constexpr size_t WS_MODF = 1 * MiB + 512 * 1024;
constexpr size_t WS_BT1 = 2 * MiB, WS_BT3 = 8 * MiB;
constexpr size_t WS_WUQT = 10 * MiB, WS_WUKT = 10 * MiB + 512 * 1024, WS_WUVT = 10 * MiB + 768 * 1024;
constexpr size_t WS_XN = 12 * MiB;
constexpr size_t WS_DQ = 44 * MiB, WS_DK = 60 * MiB, WS_DV = 76 * MiB;
constexpr size_t WS_CQ = 92 * MiB, WS_CKV = 108 * MiB, WS_KR = 116 * MiB;
constexpr size_t WS_SG = 120 * MiB;
constexpr size_t WS_QM = 152 * MiB, WS_KM = 176 * MiB, WS_VM = 200 * MiB;
constexpr size_t WS_END = 216 * MiB;
constexpr int CW_BAR = 4096;
constexpr int CW_QUEUE = 16384;
constexpr int RING_BYTES = 131072, LDSCTL_OFF = 160 * 1024 - 512, MISC_OFF = LDSCTL_OFF + 320, LDS_BYTES = 160 * 1024;

typedef float f32x16 __attribute__((ext_vector_type(16)));
typedef short s16x4 __attribute__((ext_vector_type(4)));
typedef unsigned u32x2 __attribute__((ext_vector_type(2)));

struct Args { const void* in[20]; float* out; unsigned char* ws; int ph_lo, ph_hi, li, pad; };

__device__ __forceinline__ unsigned cvtpk(float lo, float hi) { unsigned r; asm volatile("v_cvt_pk_bf16_f32 %0, %1, %2" : "=v"(r) : "v"(lo), "v"(hi)); return r; }
__device__ __forceinline__ float bf2f(unsigned short b) { return __uint_as_float((unsigned)b << 16); }
__device__ __forceinline__ float silu_f(float v) { return v / (1.f + __expf(-v)); }
__device__ __forceinline__ float wave_sum(float v) {
#pragma unroll
    for (int o = 1; o < 64; o <<= 1) v += __shfl_xor(v, o);
    return v;
}
__device__ __forceinline__ float half_swap_add(float v) {
    auto rr = __builtin_amdgcn_permlane32_swap(__float_as_uint(v), __float_as_uint(v), false, false);
    return __uint_as_float(rr[0]) + __uint_as_float(rr[1]);
}
__device__ __forceinline__ int crow(int r, int hi) { return (r & 3) + 8 * (r >> 2) + 4 * hi; }
__host__ __device__ __forceinline__ int rowperm(int n) {
    const int pn = n >> 8, q = n & 255, wc = q >> 6, j = q & 63, bj = j >> 5, fq = (j >> 3) & 3, nn = (j >> 2) & 1, e = j & 3;
    return (pn << 8) + 128 * bj + 32 * wc + 16 * nn + 4 * fq + e;
}
__device__ const double INVF[32] = {1.0, 0.7498942093324559, 0.5623413251903491, 0.4216965034285822, 0.31622776601683794, 0.23713737056616552, 0.1778279410038923, 0.1333521432163324, 0.1, 0.07498942093324558, 0.05623413251903491, 0.042169650342858224, 0.03162277660168379, 0.023713737056616554, 0.01778279410038923, 0.01333521432163324, 0.01, 0.007498942093324558, 0.005623413251903491, 0.004216965034285823, 0.0031622776601683794, 0.0023713737056616554, 0.0017782794100389228, 0.001333521432163324, 0.001, 0.0007498942093324559, 0.0005623413251903491, 0.00042169650342858224, 0.00031622776601683794, 0.00023713737056616554, 0.00017782794100389227, 0.0001333521432163324};
__device__ __forceinline__ void rope_cs(float fpos, int i, float& cs, float& sn) {
    const float ang = fpos * (float)INVF[i];
    double t = (double)ang * 0.15915494309189535; t -= __builtin_rint(t);
    const float tf = (float)t; cs = __builtin_amdgcn_cosf(tf); sn = __builtin_amdgcn_sinf(tf);
}
__device__ __forceinline__ int t5_bucket(int rel) {
    const int n = rel < 0 ? -rel : rel; int b;
    if (n < 8) b = n; else { const unsigned n2 = (unsigned)n * (unsigned)n; b = 8 + (31 - __builtin_clz(n2 >> 6)); if (b > 15) b = 15; }
    return (rel > 0 ? 16 : 0) + b;
}

struct Frame {
    LAS unsigned char* lds; volatile LAS unsigned* MISC; gu32* ctl;
    int tid, lane, wave, vcu, G;
    const float *x, *c, *rel_bias, *ada_w, *ada_b, *norm_g, *w_in, *dqn, *dkn, *dlam, *dsub, *qan, *kvan, *w_uq, *w_uk, *w_uv, *mqn, *mkn, *w_out; const int* pos;
    float* out; unsigned char* ws;
    float *MODP, *MODF, *CQ, *CKV, *KR; bf16 *BT1, *BT3, *WUQT, *WUKT, *WUVT, *XN, *A3, *DQ, *DK, *DV, *SG, *QM, *KM, *VM;
};

template <bool PERM>
__device__ __forceinline__ void p0_transpose_item(const float* W, int K, int N, bf16* WT, LAS float* scr, int item, int lane) {
    const int nblk = N / 32, kb = item / nblk, nb = item % nblk, k0 = 64 * kb, n0 = 32 * nb;
#pragma unroll 8
    for (int i = 0; i < 32; ++i) { const int kk = 2 * i + (lane >> 5); scr[kk * 33 + (lane & 31)] = W[(size_t)(k0 + kk) * N + n0 + (lane & 31)]; }
    LDS_WAIT(); asm volatile("" ::: "memory");
    const int c = lane & 7;
#pragma unroll
    for (int j = 0; j < 4; ++j) { const int n = (lane >> 3) + 8 * j; const LAS float* s = scr + (8 * c) * 33 + n;
        v4u o; o.x = pk2(s[0 * 33], s[1 * 33]); o.y = pk2(s[2 * 33], s[3 * 33]); o.z = pk2(s[4 * 33], s[5 * 33]); o.w = pk2(s[6 * 33], s[7 * 33]);
        const int row = PERM ? rowperm(n0 + n) : (n0 + n);
        *(GAS v4u*)(WT + (size_t)row * K + k0 + 8 * c) = o; }
    LDS_WAIT(); asm volatile("" ::: "memory");
}
__device__ __forceinline__ void p0_prologue(Frame& F) {
    LAS float* scr = (LAS float*)(F.lds + F.wave * 16384);
    const int gw = F.vcu * NWAVES + F.wave, NGW = F.G * NWAVES, lane = F.lane;
    constexpr int I_IN = (DM / 64) * (NIN / 32), I_OUT = (DM / 64) * (DM / 32), I_UQ = (256 / 64) * (768 / 32), I_UK = (128 / 64) * (512 / 32), I_UV = I_UK;
    constexpr int I_GEMV = 16 * 12, I_PAD = 64;
    constexpr int NITEMS = I_IN + I_OUT + I_UQ + I_UK + I_UV + I_GEMV + I_PAD + 1;
    for (int it = gw; it < NITEMS; it += NGW) {
        int r = it;
        if (r < I_IN) { p0_transpose_item<true>(F.w_in, DM, NIN, F.BT1, scr, r, lane); continue; } r -= I_IN;
        if (r < I_OUT) { p0_transpose_item<true>(F.w_out, DM, DM, F.BT3, scr, r, lane); continue; } r -= I_OUT;
        if (r < I_UQ) { p0_transpose_item<false>(F.w_uq, 256, 768, F.WUQT, scr, r, lane); continue; } r -= I_UQ;
        if (r < I_UK) { p0_transpose_item<false>(F.w_uk, 128, 512, F.WUKT, scr, r, lane); continue; } r -= I_UK;
        if (r < I_UV) { p0_transpose_item<false>(F.w_uv, 128, 512, F.WUVT, scr, r, lane); continue; } r -= I_UV;
        if (r < I_GEMV) {
            const int kq = r / 12, cg = r % 12; const GAS f32x4* wp = (const GAS f32x4*)(F.ada_w + (size_t)(64 * kq) * 3072 + 256 * cg) + lane;
            f32x4 acc = {0.f, 0.f, 0.f, 0.f};
#pragma unroll 8
            for (int k = 0; k < 64; ++k) { const float cv = F.c[64 * kq + k]; const float s = silu_f(cv); acc += wp[(size_t)k * 768] * s; }
            *((GAS f32x4*)(F.MODP + kq * 3072 + 256 * cg) + lane) = acc; continue; } r -= I_GEMV;
        if (r < I_PAD) { GAS v4u* p = (GAS v4u*)(F.BT1 + (size_t)rowperm(NIN + r) * DM) + 2 * lane; const v4u z = {0u, 0u, 0u, 0u}; p[0] = z; p[1] = z; continue; } r -= I_PAD;
        if (lane == 0) { float a = 0.f, b = 0.f; for (int d = 0; d < 64; ++d) { a += F.dlam[d] * F.dlam[64 + d]; b += F.dlam[128 + d] * F.dlam[192 + d]; }
            F.MODF[3072] = expf(a) - expf(b) + 0.2f; }
    }
}
__device__ __forceinline__ void p0b_xn(Frame& F) {
    LAS float* modL = (LAS float*)F.lds;
    { const int t = F.tid; f32x4 v = *(const GAS f32x4*)(F.ada_b + 4 * t);
#pragma unroll
      for (int kq = 0; kq < 16; ++kq) v += *(const GAS f32x4*)(F.MODP + kq * 3072 + 4 * t);
      *(LAS f32x4*)(modL + 4 * t) = v;
      if (blockIdx.x == 0 && t < 256) { f32x4 g = *(const GAS f32x4*)(F.ada_b + 2048 + 4 * t);
#pragma unroll
          for (int kq = 0; kq < 16; ++kq) g += *(const GAS f32x4*)(F.MODP + kq * 3072 + 2048 + 4 * t);
          *(GAS f32x4*)(F.MODF + 2048 + 4 * t) = g; } }
    __syncthreads();
    f32x4 a[4], sh[4];
#pragma unroll
    for (int j = 0; j < 4; ++j) { const int k = 4 * F.lane + 256 * j; const f32x4 g = *(const GAS f32x4*)(F.norm_g + k); const f32x4 sc = *(LAS f32x4*)(modL + 1024 + k);
        a[j] = g * (sc + 1.f); sh[j] = *(LAS f32x4*)(modL + k); }
    const int gw = F.vcu * NWAVES + F.wave, NGW = F.G * NWAVES;
    for (int m = gw; m < S; m += NGW) {
        const GAS f32x4* xr = (const GAS f32x4*)(F.x + (size_t)m * DM) + F.lane; f32x4 v[4]; float s = 0.f;
#pragma unroll
        for (int j = 0; j < 4; ++j) { v[j] = xr[64 * j]; s += (v[j].x * v[j].x + v[j].y * v[j].y) + (v[j].z * v[j].z + v[j].w * v[j].w); }
        const float rinv = rsqrtf(wave_sum(s) * (1.f / DM) + RMS_EPS);
        GAS u32x2* o8 = (GAS u32x2*)(F.XN + (size_t)m * DM) + F.lane;
#pragma unroll
        for (int j = 0; j < 4; ++j) { const f32x4 o = v[j] * rinv * a[j] + sh[j]; u32x2 w; w.x = cvtpk(o.x, o.y); w.y = cvtpk(o.z, o.w); o8[64 * j] = w; }
    }
    __syncthreads();
}
struct Epi1 {
    static constexpr bool PERM = false, AFTER_DRAIN = false;
    bf16 *DQ, *DK, *DV, *SG; float *CQ, *CKV, *KR; const float *gq, *gk;
    __device__ __forceinline__ void operator()(const f32x4 (&acc)[2][2][4][2], const pg8::Unit& u, int wr, int wc, int fr, int fq) const {
        const int G = u.pn * 4 + wc, rowb = u.pm * 256 + wr * 64 + fr, c8 = 8 * fq;
        if (G < 16) {
            const bool isq = G < 8; const int g8 = G & 7, h = g8 >> 1, c = g8 & 1; const float* gain = isq ? gq : gk;
            bf16* dst = (isq ? DQ : DK) + (size_t)h * S * 128 + 64 * c + c8; const float mul = isq ? DIFF_C : 1.f;
            f32x4 gv[2][2];
#pragma unroll
            for (int bj = 0; bj < 2; ++bj)
#pragma unroll
                for (int n = 0; n < 2; ++n) gv[bj][n] = *(const GAS f32x4*)(gain + 32 * bj + c8 + 4 * n);
#pragma unroll
            for (int ai = 0; ai < 2; ++ai)
#pragma unroll
                for (int m = 0; m < 4; ++m) {
                    float s = 0.f;
#pragma unroll
                    for (int bj = 0; bj < 2; ++bj)
#pragma unroll
                        for (int n = 0; n < 2; ++n) { const f32x4 v = acc[ai][bj][m][n]; s += (v.x * v.x + v.y * v.y) + (v.z * v.z + v.w * v.w); }
                    s += __shfl_xor(s, 16); s += __shfl_xor(s, 32);
                    const float rinv = rsqrtf(s * (1.f / 64.f) + RMS_EPS) * mul;
                    bf16* rp = dst + (size_t)(rowb + 128 * ai + 16 * m) * 128;
#pragma unroll
                    for (int bj = 0; bj < 2; ++bj) { const f32x4 v0 = acc[ai][bj][m][0] * rinv * gv[bj][0], v1 = acc[ai][bj][m][1] * rinv * gv[bj][1];
                        v4u w; w.x = cvtpk(v0.x, v0.y); w.y = cvtpk(v0.z, v0.w); w.z = cvtpk(v1.x, v1.y); w.w = cvtpk(v1.z, v1.w); *(GAS v4u*)(rp + 32 * bj) = w; }
                }
        } else if (G < 24 || (G >= 31 && G < 47)) {
            const bool isv = G < 24; bf16* dst; int ld;
            if (isv) { const int h = (G - 16) >> 1, half = (G - 16) & 1; dst = DV + (size_t)h * S * 128 + 64 * half + c8; ld = 128; }
            else { dst = SG + 64 * (G - 31) + c8; ld = 1024; }
#pragma unroll
            for (int ai = 0; ai < 2; ++ai)
#pragma unroll
                for (int m = 0; m < 4; ++m) { bf16* rp = dst + (size_t)(rowb + 128 * ai + 16 * m) * ld;
#pragma unroll
                    for (int bj = 0; bj < 2; ++bj) { f32x4 v0 = acc[ai][bj][m][0], v1 = acc[ai][bj][m][1];
                        if (!isv) { v0.x = silu_f(v0.x); v0.y = silu_f(v0.y); v0.z = silu_f(v0.z); v0.w = silu_f(v0.w); v1.x = silu_f(v1.x); v1.y = silu_f(v1.y); v1.z = silu_f(v1.z); v1.w = silu_f(v1.w); }
                        v4u w; w.x = cvtpk(v0.x, v0.y); w.y = cvtpk(v0.z, v0.w); w.z = cvtpk(v1.x, v1.y); w.w = cvtpk(v1.z, v1.w); *(GAS v4u*)(rp + 32 * bj) = w; } }
        } else if (G < 31) {
            float* dst; int ld;
            if (G < 28) { dst = CQ + 64 * (G - 24) + c8; ld = 256; } else if (G < 30) { dst = CKV + 64 * (G - 28) + c8; ld = 128; } else { dst = KR + c8; ld = 64; }
#pragma unroll
            for (int ai = 0; ai < 2; ++ai)
#pragma unroll
                for (int m = 0; m < 4; ++m) { float* rp = dst + (size_t)(rowb + 128 * ai + 16 * m) * ld;
#pragma unroll
                    for (int bj = 0; bj < 2; ++bj) { *(GAS f32x4*)(rp + 32 * bj) = acc[ai][bj][m][0]; *(GAS f32x4*)(rp + 32 * bj + 4) = acc[ai][bj][m][1]; } }
        }
    }
};
struct Epi3 {
    static constexpr bool PERM = false, AFTER_DRAIN = false;
    const float* x; float* out; const float* gate;
    __device__ __forceinline__ void operator()(const f32x4 (&acc)[2][2][4][2], const pg8::Unit& u, int wr, int wc, int fr, int fq) const {
        const int rowb = u.pm * 256 + wr * 64 + fr, col0 = u.pn * 256 + 64 * wc + 8 * fq;
        f32x4 gv[2][2];
#pragma unroll
        for (int bj = 0; bj < 2; ++bj)
#pragma unroll
            for (int n = 0; n < 2; ++n) gv[bj][n] = *(const GAS f32x4*)(gate + col0 + 32 * bj + 4 * n);
#pragma unroll
        for (int ai = 0; ai < 2; ++ai)
#pragma unroll
            for (int m = 0; m < 4; ++m) { const size_t off = (size_t)(rowb + 128 * ai + 16 * m) * DM + col0;
#pragma unroll
                for (int bj = 0; bj < 2; ++bj)
#pragma unroll
                    for (int n = 0; n < 2; ++n) { const f32x4 xv = *(const GAS f32x4*)(x + off + 32 * bj + 4 * n); *(GAS f32x4*)(out + off + 32 * bj + 4 * n) = xv + gv[bj][n] * acc[ai][bj][m][n]; } }
    }
};
template <int KB> __device__ __forceinline__ void stage_w(const bf16* src, char* dst, int nrows, int tid) {
    constexpr int CPR = KB / 16;
    for (int id = tid; id < nrows * CPR; id += NWAVES * 64) { const int row = id / CPR, ch = id % CPR;
        const v4u v = *(const GAS v4u*)((const char*)src + (size_t)id * 16); *(v4u*)(dst + row * KB + ((ch ^ (row & 15)) << 4)) = v; }
}
template <int KSTEPS, int KB> __device__ __forceinline__ void rowown_mma(f32x16& acc, const char* wl, int cb, const bf16x8* xf, int r32, int hi) {
    const char* rp = wl + (32 * cb + r32) * KB;
#pragma unroll
    for (int s = 0; s < KSTEPS; ++s) { const bf16x8 a = *(const bf16x8*)(rp + (((2 * s + hi) ^ (r32 & 15)) << 4)); acc = __builtin_amdgcn_mfma_f32_32x32x16_bf16(a, xf[s], acc, 0, 0, 0); }
}
__device__ __forceinline__ void p1b_q_unit(Frame& F, int rb, int h, char* lds) {
    int lane_o = F.lane; asm volatile("" : "+v"(lane_o));
    const int lane = lane_o, r32 = lane & 31, hi = lane >> 5, row = 256 * rb + 32 * F.wave + r32;
    __syncthreads();
    stage_w<512>(F.WUQT + (size_t)192 * h * 256, lds, 192, F.tid);
    bf16x8 xf[16]; float ssq = 0.f;
    { const float* xr = F.CQ + (size_t)row * 256 + 8 * hi;
#pragma unroll
      for (int s = 0; s < 16; ++s) { const f32x4 x0 = *(const GAS f32x4*)(xr + 16 * s), x1 = *(const GAS f32x4*)(xr + 16 * s + 4);
          const f32x4 g0 = *(const GAS f32x4*)(F.qan + 16 * s + 8 * hi), g1 = *(const GAS f32x4*)(F.qan + 16 * s + 8 * hi + 4);
          ssq += (x0.x * x0.x + x0.y * x0.y) + (x0.z * x0.z + x0.w * x0.w) + (x1.x * x1.x + x1.y * x1.y) + (x1.z * x1.z + x1.w * x1.w);
          const f32x4 y0 = x0 * g0, y1 = x1 * g1; v4u w; w.x = cvtpk(y0.x, y0.y); w.y = cvtpk(y0.z, y0.w); w.z = cvtpk(y1.x, y1.y); w.w = cvtpk(y1.z, y1.w); xf[s] = __builtin_bit_cast(bf16x8, w); } }
    const float rinv_a = rsqrtf(half_swap_add(ssq) * (1.f / 256.f) + RMS_EPS);
    __syncthreads();
    f32x16 acc[6];
#pragma unroll
    for (int cb = 0; cb < 6; ++cb) { acc[cb] = f32x16{}; rowown_mma<16, 512>(acc[cb], lds, cb, xf, r32, hi); }
    const float fpos = (float)F.pos[row]; float s2 = 0.f;
#pragma unroll
    for (int r = 0; r < 16; ++r) { float cs, sn; rope_cs(fpos, crow(r, hi), cs, sn);
        const float x1 = acc[4][r] * rinv_a, x2 = acc[5][r] * rinv_a; acc[4][r] = x1 * cs - x2 * sn; acc[5][r] = x2 * cs + x1 * sn; }
#pragma unroll
    for (int cb = 0; cb < 4; ++cb)
#pragma unroll
        for (int r = 0; r < 16; ++r) acc[cb][r] *= rinv_a;
#pragma unroll
    for (int cb = 0; cb < 6; ++cb)
#pragma unroll
        for (int r = 0; r < 16; ++r) s2 += acc[cb][r] * acc[cb][r];
    const float rinv2 = rsqrtf(half_swap_add(s2) * (1.f / 192.f) + RMS_EPS) * MLA_C;
    bf16* qrow = F.QM + ((size_t)h * S + row) * 192 + 4 * hi;
#pragma unroll
    for (int cb = 0; cb < 6; ++cb)
#pragma unroll
        for (int g = 0; g < 4; ++g) { const f32x4 gn = *(const GAS f32x4*)(F.mqn + 32 * cb + 8 * g + 4 * hi);
            u32x2 w; w.x = cvtpk(acc[cb][4 * g] * rinv2 * gn.x, acc[cb][4 * g + 1] * rinv2 * gn.y); w.y = cvtpk(acc[cb][4 * g + 2] * rinv2 * gn.z, acc[cb][4 * g + 3] * rinv2 * gn.w);
            *(GAS u32x2*)(qrow + 32 * cb + 8 * g) = w; }
}
__device__ __forceinline__ void p1b_kv_unit(Frame& F, int rb, int h, char* lds) {
    int lane_o = F.lane; asm volatile("" : "+v"(lane_o));
    const int lane = lane_o, r32 = lane & 31, hi = lane >> 5, row = 256 * rb + 32 * F.wave + r32;
    __syncthreads();
    stage_w<256>(F.WUKT + (size_t)128 * h * 128, lds, 128, F.tid);
    stage_w<256>(F.WUVT + (size_t)128 * h * 128, lds + 32768, 128, F.tid);
    bf16x8 xf[8]; float ssq = 0.f;
    { const float* xr = F.CKV + (size_t)row * 128 + 8 * hi;
#pragma unroll
      for (int s = 0; s < 8; ++s) { const f32x4 x0 = *(const GAS f32x4*)(xr + 16 * s), x1 = *(const GAS f32x4*)(xr + 16 * s + 4);
          const f32x4 g0 = *(const GAS f32x4*)(F.kvan + 16 * s + 8 * hi), g1 = *(const GAS f32x4*)(F.kvan + 16 * s + 8 * hi + 4);
          ssq += (x0.x * x0.x + x0.y * x0.y) + (x0.z * x0.z + x0.w * x0.w) + (x1.x * x1.x + x1.y * x1.y) + (x1.z * x1.z + x1.w * x1.w);
          const f32x4 y0 = x0 * g0, y1 = x1 * g1; v4u w; w.x = cvtpk(y0.x, y0.y); w.y = cvtpk(y0.z, y0.w); w.z = cvtpk(y1.x, y1.y); w.w = cvtpk(y1.z, y1.w); xf[s] = __builtin_bit_cast(bf16x8, w); } }
    const float rinv_a = rsqrtf(half_swap_add(ssq) * (1.f / 128.f) + RMS_EPS);
    __syncthreads();
    { f32x16 av[4];
#pragma unroll
      for (int cb = 0; cb < 4; ++cb) { av[cb] = f32x16{}; rowown_mma<8, 256>(av[cb], lds + 32768, cb, xf, r32, hi); }
      bf16* vrow = F.VM + ((size_t)h * S + row) * 128 + 4 * hi;
#pragma unroll
      for (int cb = 0; cb < 4; ++cb)
#pragma unroll
          for (int g = 0; g < 4; ++g) { u32x2 w; w.x = cvtpk(av[cb][4 * g] * rinv_a, av[cb][4 * g + 1] * rinv_a); w.y = cvtpk(av[cb][4 * g + 2] * rinv_a, av[cb][4 * g + 3] * rinv_a);
              *(GAS u32x2*)(vrow + 32 * cb + 8 * g) = w; } }
    f32x16 ak[4];
#pragma unroll
    for (int cb = 0; cb < 4; ++cb) { ak[cb] = f32x16{}; rowown_mma<8, 256>(ak[cb], lds, cb, xf, r32, hi); }
    float pe1[16], pe2[16]; const float fpos = (float)F.pos[row]; float s2 = 0.f;
    { const float* kr = F.KR + (size_t)row * 64 + 4 * hi;
#pragma unroll
      for (int g = 0; g < 4; ++g) { const f32x4 a = *(const GAS f32x4*)(kr + 8 * g), b = *(const GAS f32x4*)(kr + 32 + 8 * g);
          pe1[4 * g] = a.x; pe1[4 * g + 1] = a.y; pe1[4 * g + 2] = a.z; pe1[4 * g + 3] = a.w; pe2[4 * g] = b.x; pe2[4 * g + 1] = b.y; pe2[4 * g + 2] = b.z; pe2[4 * g + 3] = b.w; } }
#pragma unroll
    for (int r = 0; r < 16; ++r) { float cs, sn; rope_cs(fpos, crow(r, hi), cs, sn); const float x1 = pe1[r], x2 = pe2[r]; pe1[r] = x1 * cs - x2 * sn; pe2[r] = x2 * cs + x1 * sn; s2 += pe1[r] * pe1[r] + pe2[r] * pe2[r]; }
#pragma unroll
    for (int cb = 0; cb < 4; ++cb)
#pragma unroll
        for (int r = 0; r < 16; ++r) { ak[cb][r] *= rinv_a; s2 += ak[cb][r] * ak[cb][r]; }
    const float rinv2 = rsqrtf(half_swap_add(s2) * (1.f / 192.f) + RMS_EPS);
    bf16* krow = F.KM + ((size_t)h * S + row) * 192 + 4 * hi;
#pragma unroll
    for (int cb = 0; cb < 4; ++cb)
#pragma unroll
        for (int g = 0; g < 4; ++g) { const f32x4 gn = *(const GAS f32x4*)(F.mkn + 32 * cb + 8 * g + 4 * hi);
            u32x2 w; w.x = cvtpk(ak[cb][4 * g] * rinv2 * gn.x, ak[cb][4 * g + 1] * rinv2 * gn.y); w.y = cvtpk(ak[cb][4 * g + 2] * rinv2 * gn.z, ak[cb][4 * g + 3] * rinv2 * gn.w);
            *(GAS u32x2*)(krow + 32 * cb + 8 * g) = w; }
#pragma unroll
    for (int g = 0; g < 4; ++g) { const f32x4 g1 = *(const GAS f32x4*)(F.mkn + 128 + 8 * g + 4 * hi), g2 = *(const GAS f32x4*)(F.mkn + 160 + 8 * g + 4 * hi);
        u32x2 w; w.x = cvtpk(pe1[4 * g] * rinv2 * g1.x, pe1[4 * g + 1] * rinv2 * g1.y); w.y = cvtpk(pe1[4 * g + 2] * rinv2 * g1.z, pe1[4 * g + 3] * rinv2 * g1.w); *(GAS u32x2*)(krow + 128 + 8 * g) = w;
        w.x = cvtpk(pe2[4 * g] * rinv2 * g2.x, pe2[4 * g + 1] * rinv2 * g2.y); w.y = cvtpk(pe2[4 * g + 2] * rinv2 * g2.z, pe2[4 * g + 3] * rinv2 * g2.w); *(GAS u32x2*)(krow + 160 + 8 * g) = w; }
}
__device__ __forceinline__ void p1b_phase(Frame& F) {
    char* lds = (char*)F.lds;
    for (int u = blockIdx.x; u < 256; u += F.G) { p1b_q_unit(F, u >> 2, u & 3, lds); p1b_kv_unit(F, u >> 2, u & 3, lds); }
    __syncthreads();
}
}
namespace mk {
constexpr int AL_V = 0, AL_K = 32768, AL_WS = 32768 + 49152, AL_TBL = AL_WS + 2048, AL_BC = AL_TBL + 1024, AL_X = 0;
#define SBAR() __builtin_amdgcn_sched_barrier(0)
#ifndef QK_SB
#define QK_SB 4
#endif
__device__ __forceinline__ int v_st(int k, int c) { return ((k >> 3) * 4 + (c >> 5)) * 512 + ((k & 7) * 32 + (c & 31)) * 2; }
__device__ __forceinline__ int v_rd_base(int lane) { return ((lane & 3) << 3) | (((lane >> 2) & 3) << 6) | (((lane >> 4) & 1) << 5) | (((lane >> 5) & 1) << 8); }
constexpr int v_rd_off(int d0, int ks, int half) { return d0 * 512 + ks * 4096 + half * 2048; }
template <int OFF> __device__ __forceinline__ s16x4 tr_read(int vb) { s16x4 r; asm volatile("ds_read_b64_tr_b16 %0, %1 offset:%2" : "=&v"(r) : "v"(vb), "i"(OFF) : "memory"); return r; }
template <int D0> __device__ __forceinline__ void pv_one(f32x16& od, int vb, bf16x8 pa0, bf16x8 pa1, bf16x8 pa2, bf16x8 pa3) {
    const s16x4 l0 = tr_read<v_rd_off(D0, 0, 0)>(vb), h0 = tr_read<v_rd_off(D0, 0, 1)>(vb), l1 = tr_read<v_rd_off(D0, 1, 0)>(vb), h1 = tr_read<v_rd_off(D0, 1, 1)>(vb);
    const s16x4 l2 = tr_read<v_rd_off(D0, 2, 0)>(vb), h2 = tr_read<v_rd_off(D0, 2, 1)>(vb), l3 = tr_read<v_rd_off(D0, 3, 0)>(vb), h3 = tr_read<v_rd_off(D0, 3, 1)>(vb);
    asm volatile("s_waitcnt lgkmcnt(0)" ::: "memory"); SBAR();
#define PK(L, H) (bf16x8){L[0], L[1], L[2], L[3], H[0], H[1], H[2], H[3]}
    od = __builtin_amdgcn_mfma_f32_32x32x16_bf16(pa0, PK(l0, h0), od, 0, 0, 0);
    od = __builtin_amdgcn_mfma_f32_32x32x16_bf16(pa1, PK(l1, h1), od, 0, 0, 0);
    od = __builtin_amdgcn_mfma_f32_32x32x16_bf16(pa2, PK(l2, h2), od, 0, 0, 0);
    od = __builtin_amdgcn_mfma_f32_32x32x16_bf16(pa3, PK(l3, h3), od, 0, 0, 0);
#undef PK
}
__device__ __forceinline__ void pv_all(f32x16* o, int vb, bf16x8 pa0, bf16x8 pa1, bf16x8 pa2, bf16x8 pa3) {
    pv_one<0>(o[0], vb, pa0, pa1, pa2, pa3); pv_one<1>(o[1], vb, pa0, pa1, pa2, pa3); pv_one<2>(o[2], vb, pa0, pa1, pa2, pa3); pv_one<3>(o[3], vb, pa0, pa1, pa2, pa3);
}
__device__ __forceinline__ bf16x8 pack8(const f32x16& p, int b) {
    v4u w; w.x = cvtpk(p[b], p[b + 1]); w.y = cvtpk(p[b + 2], p[b + 3]); w.z = cvtpk(p[b + 4], p[b + 5]); w.w = cvtpk(p[b + 6], p[b + 7]); return __builtin_bit_cast(bf16x8, w);
}
template <int D0, int HF> __device__ __forceinline__ void pv_half(f32x16& od, int vb, bf16x8 pa0, bf16x8 pa1) {
    const s16x4 l0 = tr_read<v_rd_off(D0, 2 * HF, 0)>(vb), h0 = tr_read<v_rd_off(D0, 2 * HF, 1)>(vb), l1 = tr_read<v_rd_off(D0, 2 * HF + 1, 0)>(vb), h1 = tr_read<v_rd_off(D0, 2 * HF + 1, 1)>(vb);
    asm volatile("s_waitcnt lgkmcnt(0)" ::: "memory"); SBAR();
#define PK(L, H) (bf16x8){L[0], L[1], L[2], L[3], H[0], H[1], H[2], H[3]}
    od = __builtin_amdgcn_mfma_f32_32x32x16_bf16(pa0, PK(l0, h0), od, 0, 0, 0);
    od = __builtin_amdgcn_mfma_f32_32x32x16_bf16(pa1, PK(l1, h1), od, 0, 0, 0);
#undef PK
}
template <int HF> __device__ __forceinline__ void pv_h(f32x16* o, int vb, bf16x8 pa0, bf16x8 pa1) {
    pv_half<0, HF>(o[0], vb, pa0, pa1); pv_half<1, HF>(o[1], vb, pa0, pa1); pv_half<2, HF>(o[2], vb, pa0, pa1); pv_half<3, HF>(o[3], vb, pa0, pa1);
}
template <bool DIFF>
__device__ __forceinline__ void attn_unit(Frame& F, int h, int qb, char* lds) {
    constexpr int KSTEPS = DIFF ? 4 : 12, KROWB = DIFF ? 256 : 384, KTILE = 64 * KROWB, NKC = KTILE / (512 * 16), KBUF = 24576, VBUF = 16384;
    int tid_o = F.tid; asm volatile("" : "+v"(tid_o));
    const int tid = tid_o, wid = F.wave, lane = tid & 63, r32 = lane & 31, hi = lane >> 5;
    const int cmap = DIFF ? (wid >> 2) : 0, rg = DIFF ? (wid & 3) : wid;
    const int R0 = (DIFF ? 128 : 256) * qb, myrow = R0 + 32 * rg + r32;
    const int chunk_w = (DIFF ? 2 * qb : 4 * qb) + (rg >> 1), NT = (DIFF ? 2 * qb : 4 * qb) + (DIFF ? 2 : 4);
    char* V_lds = lds + AL_V; char* K_lds = lds + AL_K; float* wsf = (float*)(lds + AL_WS) + wid * 64; float* tbl = (float*)(lds + AL_TBL);
    const bf16* Kg = (DIFF ? F.DK + (size_t)h * S * 128 : F.KM + (size_t)h * S * 192);
    const bf16* Vg = (DIFF ? F.DV : F.VM) + (size_t)h * S * 128;
    if (DIFF) { if (tid < 255) { const int rel = tid - 191; tbl[tid] = (F.rel_bias[t5_bucket(rel) * 4 + h] - F.rel_bias[15 * 4 + h]) * LOG2E; } }
    bf16x8 qr[KSTEPS];
    { const bf16* Qw = DIFF ? F.DQ + ((size_t)h * S + myrow) * 128 + 64 * cmap + 8 * hi : F.QM + ((size_t)h * S + myrow) * 192 + 8 * hi;
#pragma unroll
      for (int d0 = 0; d0 < KSTEPS; ++d0) qr[d0] = *(const GAS bf16x8*)(Qw + 16 * d0); }
    auto kst = [&](int i) -> int { const int id = tid + 512 * i; if (DIFF) { const int row = id >> 4, ch = id & 15; return row * 256 + ((ch ^ (row & 7)) << 4); } else { const int row = id / 24, ch = id % 24; return row * 384 + ((ch ^ ((row >> 1) & 7)) << 4); } };
    auto vst = [&](int i) -> int { const int id = tid + 512 * i; return v_st(id >> 4, (id & 15) * 8); };
    const int vb0 = (int)(uintptr_t)V_lds + v_rd_base(lane);
    const int kro = r32 * KROWB, kx = DIFF ? ((r32 & 7) << 4) : (((r32 >> 1) & 7) << 4);
    const int tb0 = 191 + 4 * hi - (32 * (rg & 1) + r32) - 64 * chunk_w;
    bf16x8 sk[NKC], sv[2];
#define SLOAD(t) do { _Pragma("unroll") for (int i_ = 0; i_ < NKC; ++i_) sk[i_] = *(const GAS bf16x8*)(Kg + (size_t)(t) * (KTILE / 2) + (size_t)(tid + 512 * i_) * 8); \
        _Pragma("unroll") for (int i_ = 0; i_ < 2; ++i_) sv[i_] = *(const GAS bf16x8*)(Vg + (size_t)(t) * 8192 + (size_t)(tid + 512 * i_) * 8); } while (0)
#define SWRITE(b) do { _Pragma("unroll") for (int i_ = 0; i_ < NKC; ++i_) *(bf16x8*)(K_lds + (b) * KBUF + kst(i_)) = sk[i_]; \
        _Pragma("unroll") for (int i_ = 0; i_ < 2; ++i_) *(bf16x8*)(V_lds + (b) * VBUF + vst(i_)) = sv[i_]; } while (0)
#define QKT_H(P, b, HF) do { P = f32x16{}; const char* kb_ = K_lds + (b) * KBUF + (HF) * 32 * KROWB + kro; \
        _Pragma("unroll") for (int d0 = 0; d0 < KSTEPS; ++d0) { const int cb_ = DIFF ? ((64 * cmap + 16 * d0 + 8 * hi) * 2) : ((2 * d0 + hi) << 4); \
            const bf16x8 b0_ = *(const bf16x8*)(kb_ + (cb_ ^ kx)); P = __builtin_amdgcn_mfma_f32_32x32x16_bf16(b0_, qr[d0], P, 0, 0, 0); if (QK_SB && (d0 % QK_SB) == QK_SB - 1 && d0 != KSTEPS - 1) SBAR(); } } while (0)
#define POSTQK_H(P, t, HF) do { if ((t) > chunk_w) { _Pragma("unroll") for (int r = 0; r < 16; ++r) P[r] = -1e30f; } \
        else if (DIFF && (t) + 2 >= chunk_w) { const float* tb_ = tbl + (tb0 + 64 * (t) + 32 * (HF)); \
            _Pragma("unroll") for (int r = 0; r < 16; ++r) P[r] += tb_[(r & 3) + 8 * (r >> 2)]; } } while (0)
#define FINISH_H(P) do { _Pragma("unroll") for (int r = 0; r < 16; ++r) P[r] = __builtin_amdgcn_exp2f(P[r]); float ps_ = 0.f; \
        _Pragma("unroll") for (int r = 0; r < 16; ++r) ps_ += P[r]; l_reg += ps_; pa0 = pack8(P, 0); pa1 = pack8(P, 8); } while (0)
    float l_reg = 0.f; f32x16 o[4] = {}; f32x16 Pa, Pb; bf16x8 pa0, pa1;
    __syncthreads();
    SLOAD(0); SWRITE(0); SLOAD(1); __syncthreads();
    QKT_H(Pa, 0, 0); POSTQK_H(Pa, 0, 0);
    SWRITE(1); if (2 < NT) SLOAD(2);
    SBAR(); QKT_H(Pb, 0, 1); POSTQK_H(Pb, 0, 1); FINISH_H(Pa); SBAR(); pv_h<0>(o, vb0, pa0, pa1);
    __syncthreads();
    for (int t = 1; t < NT; ++t) {
        const int b = t & 1;
        SBAR(); QKT_H(Pa, b, 0); POSTQK_H(Pa, t, 0); FINISH_H(Pb); SBAR(); pv_h<1>(o, vb0 + (b ^ 1) * VBUF, pa0, pa1);
        __syncthreads();
        if (t + 1 < NT) { SWRITE(b ^ 1); if (t + 2 < NT) SLOAD(t + 2); }
        SBAR(); QKT_H(Pb, b, 1); POSTQK_H(Pb, t, 1); FINISH_H(Pa); SBAR(); pv_h<0>(o, vb0 + b * VBUF, pa0, pa1);
        __syncthreads();
    }
    FINISH_H(Pb); SBAR(); pv_h<1>(o, vb0 + ((NT - 1) & 1) * VBUF, pa0, pa1);
    const float l_tot = half_swap_add(l_reg);
    if (hi == 0) wsf[r32] = l_tot; asm volatile("s_waitcnt lgkmcnt(0)" ::: "memory");
    float rli[16];
#pragma unroll
    for (int r = 0; r < 16; ++r) rli[r] = __builtin_amdgcn_rcpf(wsf[crow(r, hi)]);
    __syncthreads();
    if (DIFF) {
        float* X = (float*)(lds + AL_X) + rg * 4096 + lane;
        if (cmap == 1) { const float lam = F.MODF[3072];
#pragma unroll
            for (int d0 = 0; d0 < 4; ++d0)
#pragma unroll
                for (int r = 0; r < 16; ++r) X[(d0 * 16 + r) * 64] = lam * o[d0][r] * rli[r];
        }
        __syncthreads();
        if (cmap == 0) {
#pragma unroll
            for (int r = 0; r < 16; ++r) { float s = 0.f;
#pragma unroll
                for (int d0 = 0; d0 < 4; ++d0) { o[d0][r] = o[d0][r] * rli[r] - X[(d0 * 16 + r) * 64]; s += o[d0][r] * o[d0][r]; }
                s += __shfl_xor(s, 1); s += __shfl_xor(s, 2); s += __shfl_xor(s, 4); s += __shfl_xor(s, 8); s += __shfl_xor(s, 16);
                rli[r] = rsqrtf(s * (1.f / 128.f) + RMS_EPS) * 0.8f; }
#pragma unroll
            for (int d0 = 0; d0 < 4; ++d0) { const int col = h * 128 + 32 * d0 + r32; const float gs = F.dsub[32 * d0 + r32];
#pragma unroll
                for (int r = 0; r < 16; ++r) { const size_t off = (size_t)(R0 + 32 * rg + crow(r, hi)) * DM + col;
                    const float sg = bf2f(F.SG[off]); F.A3[off] = (bf16)(cvtpk(o[d0][r] * rli[r] * gs * sg, 0.f) & 0xffffu); }
                asm volatile("" ::: "memory"); }
        }
    } else {
#pragma unroll
        for (int d0 = 0; d0 < 4; ++d0) { const int col = 512 + h * 128 + 32 * d0 + r32;
#pragma unroll
            for (int r = 0; r < 16; ++r) { const size_t off = (size_t)(R0 + 32 * rg + crow(r, hi)) * DM + col;
                const float sg = bf2f(F.SG[off]); F.A3[off] = (bf16)(cvtpk(o[d0][r] * rli[r] * sg, 0.f) & 0xffffu); }
            asm volatile("" ::: "memory"); }
    }
#undef SLOAD
#undef SWRITE
#undef QKT_H
#undef POSTQK_H
#undef FINISH_H
}
__device__ __forceinline__ void attn_phase(Frame& F) {
    char* lds = (char*)F.lds; volatile int* bc = (volatile int*)(lds + AL_BC);
    const int home = blockIdx.x & 7;
    for (int tt = 0; tt < 8; ++tt) {
        const int T = (home + tt) & 7, NU = T < 4 ? 128 : 64;
        for (;;) {
            __syncthreads();
            if (F.tid == 0) bc[0] = (int)__hip_atomic_fetch_add(F.ctl + CW_QUEUE + 64 * T, 1u, __ATOMIC_RELAXED, __HIP_MEMORY_SCOPE_AGENT);
            __syncthreads();
            const int idx = bc[0];
            if (idx >= NU) break;
#ifndef ATT_ONLY
#define ATT_ONLY 3
#endif
            if (T < 4) { if (ATT_ONLY & 1) attn_unit<true>(F, T, NU - 1 - idx, lds); } else { if (ATT_ONLY & 2) attn_unit<false>(F, T - 4, NU - 1 - idx, lds); }
        }
    }
    __syncthreads();
}
#undef SBAR
}
__global__ void __launch_bounds__(512, 2) mk_fwd(mk::Args args) {
    using namespace mk;
    extern __shared__ __attribute__((aligned(16))) unsigned char lds[];
    Frame F;
    F.lds = (LAS unsigned char*)lds; F.MISC = (volatile LAS unsigned*)(F.lds + MISC_OFF);
    F.tid = threadIdx.x; F.lane = F.tid & 63; F.wave = __builtin_amdgcn_readfirstlane(F.tid >> 6);
    F.G = gridDim.x; { const int bx = blockIdx.x; F.vcu = (F.G % 8 == 0) ? (bx % 8) * (F.G / 8) + bx / 8 : bx; }
    unsigned char* ws = args.ws; F.ws = ws; F.ctl = (gu32*)(ws + WS_CTL);
    F.x = (const float*)args.in[0]; F.c = (const float*)args.in[1]; F.pos = (const int*)args.in[2]; F.rel_bias = (const float*)args.in[3];
    F.ada_w = (const float*)args.in[4]; F.ada_b = (const float*)args.in[5]; F.norm_g = (const float*)args.in[6]; F.w_in = (const float*)args.in[7];
    F.dqn = (const float*)args.in[8]; F.dkn = (const float*)args.in[9]; F.dlam = (const float*)args.in[10]; F.dsub = (const float*)args.in[11];
    F.qan = (const float*)args.in[12]; F.kvan = (const float*)args.in[13]; F.w_uq = (const float*)args.in[14]; F.w_uk = (const float*)args.in[15];
    F.w_uv = (const float*)args.in[16]; F.mqn = (const float*)args.in[17]; F.mkn = (const float*)args.in[18]; F.w_out = (const float*)args.in[19];
    F.out = args.out;
    F.MODP = (float*)(ws + WS_MODP); F.MODF = (float*)(ws + WS_MODF); F.CQ = (float*)(ws + WS_CQ); F.CKV = (float*)(ws + WS_CKV); F.KR = (float*)(ws + WS_KR);
    F.BT1 = (bf16*)(ws + WS_BT1); F.BT3 = (bf16*)(ws + WS_BT3); F.WUQT = (bf16*)(ws + WS_WUQT); F.WUKT = (bf16*)(ws + WS_WUKT); F.WUVT = (bf16*)(ws + WS_WUVT);
    F.XN = (bf16*)(ws + WS_XN); F.A3 = (bf16*)(ws + WS_XN); F.DQ = (bf16*)(ws + WS_DQ); F.DK = (bf16*)(ws + WS_DK); F.DV = (bf16*)(ws + WS_DV); F.SG = (bf16*)(ws + WS_SG);
    F.QM = (bf16*)(ws + WS_QM); F.KM = (bf16*)(ws + WS_KM); F.VM = (bf16*)(ws + WS_VM);
    for (int u = F.tid; u < (LDS_BYTES - LDSCTL_OFF) / 4; u += NWAVES * 64) ((LAS unsigned*)(F.lds + LDSCTL_OFF))[u] = 0u;
    __syncthreads();
    XcdBarrier bar = xcd_barrier_post((unsigned*)(F.ctl + CW_BAR) + args.li * XCD_BAR_WORDS, F.MISC + 8);
    const int lo = args.ph_lo, hi = args.ph_hi;
#define IN(k) (lo <= (k) && (k) < hi)
#ifndef PH_MASK
#define PH_MASK 63
#endif
#define PHM(k) (((PH_MASK) >> (k)) & 1)
    if (PHM(0) && IN(0)) { p0_prologue(F); if (IN(1)) xcd_barrier(bar); }
    if (PHM(1) && IN(1)) { p0b_xn(F); if (IN(2)) xcd_barrier(bar); }
    if (PHM(2) && IN(2)) {
        pg8::Gemm g{F.XN, F.BT1, S, NINP, DM}; pg8::StaticOrder So; So.init(S, NINP, F.G, (int)blockIdx.x);
        Epi1 E{F.DQ, F.DK, F.DV, F.SG, F.CQ, F.CKV, F.KR, F.dqn, F.dkn};
        pg8::gemm_phase<Epi1, pg8::StaticOrder, true, true>(F.lds, g, So, E);
        if (IN(3)) xcd_barrier(bar);
    }
    if (PHM(3) && IN(3)) { p1b_phase(F); if (IN(4)) xcd_barrier(bar); }
    if (PHM(4) && IN(4)) { attn_phase(F); if (IN(5)) xcd_barrier(bar); }
    if (PHM(5) && IN(5)) {
        pg8::Gemm g{F.A3, F.BT3, S, DM, DM}; pg8::StaticOrder So; So.init(S, DM, F.G, (int)blockIdx.x);
        Epi3 E{F.x, F.out, F.MODF + 2048};
        pg8::gemm_phase<Epi3, pg8::StaticOrder, false, true>(F.lds, g, So, E);
    }
#undef IN
}
static int mk_grid = 0;
static void mk_launch(void* const* d_in, void* d_out, void* d_ws, hipStream_t stream, int ph_lo, int ph_hi, int li) {
    using namespace mk;
    if (mk_grid == 0) {
        int dev = 0, cus = 0;
        if (hipGetDevice(&dev) != hipSuccess || hipDeviceGetAttribute(&cus, hipDeviceAttributeMultiprocessorCount, dev) != hipSuccess) { fprintf(stderr, "kernel_launch: device query failed\n"); mk_grid = -1; return; }
        if (hipFuncSetAttribute((const void*)mk_fwd, hipFuncAttributeMaxDynamicSharedMemorySize, LDS_BYTES) != hipSuccess) { fprintf(stderr, "kernel_launch: hipFuncSetAttribute failed\n"); mk_grid = -1; return; }
        int per_cu = 0; (void)hipOccupancyMaxActiveBlocksPerMultiprocessor(&per_cu, (const void*)mk_fwd, NWAVES * 64, LDS_BYTES); (void)hipGetLastError();
        if (per_cu < 1) fprintf(stderr, "kernel_launch: note: occupancy query reports %d blocks per CU\n", per_cu);
        mk_grid = cus;
    }
    if (mk_grid < 0) return;
    if (li == 0) (void)hipMemsetAsync((char*)d_ws + WS_CTL, 0, CTL_ZERO_BYTES, stream);
    Args a{}; for (int i = 0; i < 20; ++i) a.in[i] = d_in[i]; a.out = (float*)d_out; a.ws = (unsigned char*)d_ws;
    a.ph_lo = ph_lo; a.ph_hi = ph_hi; a.li = li; a.pad = 0;
    hipLaunchKernelGGL(mk_fwd, dim3(mk_grid), dim3(NWAVES * 64), LDS_BYTES, stream, a);
    const hipError_t le = hipPeekAtLastError();
    if (le != hipSuccess) fprintf(stderr, "kernel_launch: launch failed: %s\n", hipGetErrorName(le));
}
extern "C" void kernel_launch(void* const* d_in, const int* in_sizes, int n_in, void* d_out, int out_size, void* d_ws, size_t ws_size, hipStream_t stream) {
    mk_launch(d_in, d_out, d_ws, stream, 0, 6, 0);
}
```

```cpp
#include <hip/hip_runtime.h>
#include <hip/hip_bf16.h>
#include <cstdio>
#include <cstdint>
namespace pg8 {
#define PG8_LAS __attribute__((address_space(3)))
typedef unsigned short bf16_t;
typedef short bf16x8 __attribute__((ext_vector_type(8)));
typedef float f32x4 __attribute__((ext_vector_type(4)));
typedef unsigned u32x4 __attribute__((ext_vector_type(4)));
constexpr int BM = 256, BK = 64, HALF = 128, HTB = HALF * BK * 2  , STAGE_BYTES = 8 * HTB, NXCD = 8, WGM = 8;

__host__ __device__ __forceinline__ int lds_byte(int r, int c) { const int st = (r >> 4) * 2 + (c >> 5), rr = r & 15, cc = c & 31, ob = rr * 64 + cc * 2; return st * 1024 + (ob ^ (((ob >> 9) & 1) << 5)); }
__host__ __device__ __forceinline__ void stage_rc(int b, int& R, int& C) { const int st = b / 1024, sb = b % 1024, swz = sb ^ (((sb >> 9) & 1) << 5); R = (st >> 1) * 16 + swz / 64; C = (st & 1) * 32 + (swz % 64) / 2; }
__host__ __device__ __forceinline__ int perm32(int rho) { const int n = rho >> 4, i = rho & 15; return 8 * (i >> 2) + 4 * n + (i & 3); }

struct Unit { int pm, pn; };
struct Gemm { const bf16_t* A; const bf16_t* Bt; int M, N, K; };

struct StaticOrder {
    int nM, nN, nwg, G, c;
    __host__ __device__ void init(int M, int N, int G_, int c_) { nM = M / BM; nN = N / BM; nwg = nM * nN; G = G_; c = c_; }
    __host__ __device__ bool next(int i, Unit& u) const {
        const long L = (long)i * G + c; if (L >= nwg) return false;
        int wgid = (int)L; { const int q = nwg / NXCD, r = nwg % NXCD, xcd = wgid % NXCD, off = wgid / NXCD; wgid = (xcd < r ? xcd * (q + 1) : r * (q + 1) + (xcd - r) * q) + off; }
        const int nig = WGM * nN, gid = wgid / nig, fm = gid * WGM, gsz = (nM - fm) < WGM ? (nM - fm) : WGM;
        u.pm = fm + ((wgid % nig) % gsz); u.pn = (wgid % nig) / gsz; return true;
    }
    __device__ __forceinline__ void a_ready(const Unit&) const {}
    __device__ __forceinline__ void done(const Unit&) const {}
};
struct FixedOrder {
    int pm, pn;
    __device__ __forceinline__ bool next(int i, Unit& u) const { if (i != 0) return false; u.pm = pm; u.pn = pn; return true; }
    __device__ __forceinline__ void a_ready(const Unit&) const {}
    __device__ __forceinline__ void done(const Unit&) const {}
};
__device__ __forceinline__ unsigned cvt_pk_bf16(float lo, float hi) { unsigned r; asm volatile("v_cvt_pk_bf16_f32 %0, %1, %2" : "=v"(r) : "v"(lo), "v"(hi)); return r; }
typedef float f32x2 __attribute__((ext_vector_type(2)));
template <class Epi, class Sched, bool ALIGN_EPI = false, bool SP2 = false>
__device__ __forceinline__ void gemm_phase(PG8_LAS unsigned char* lds, const Gemm g, const Sched& S, const Epi& E, const int wave_sgpr) {
    const int lane = (int)__builtin_amdgcn_mbcnt_hi(~0u, __builtin_amdgcn_mbcnt_lo(~0u, 0u)), wid = wave_sgpr, tid = wid * 64 + lane, wr = wid >> 2, wc = wid & 3, fr = lane & 15, fq = lane >> 4;
    const int K = g.K, nt = K / BK;
    unsigned voffA[2], voffB[2];
#pragma unroll
    for (int i = 0; i < 2; ++i) { int R, C; stage_rc(tid * 16 + i * 8192, R, C); const int Rb = Epi::PERM ? ((R & ~31) + perm32(R & 31)) : R;
        voffA[i] = (unsigned)(R * K + C) * 2u; voffB[i] = (unsigned)(Rb * K + C) * 2u; }
    const size_t kstep = (size_t)(BK * 2);
    const size_t hstep = (size_t)HALF * K * 2;
    const size_t tstep = 2 * hstep;
    const unsigned ldsw = (unsigned)wid * 1024u;
    const int aoff = lds_byte(wr * 64 + fr, fq * 8), boff = lds_byte(wc * 32 + fr, fq * 8);
#define PG8_SA(b, h) (((b) * 2 + (h)) * HTB)
#define PG8_SB(b, h) ((4 + (b) * 2 + (h)) * HTB)
#define PG8_STAGE(bufoff, gbase, voff) do { _Pragma("unroll") for (int _i = 0; _i < 2; ++_i) \
        __builtin_amdgcn_global_load_lds((const unsigned*)((const char*)(gbase) + (voff)[_i]), (PG8_LAS unsigned*)(lds + (bufoff) + ldsw + _i * 8192), 16, 0, 0); } while (0)
#define PG8_LDA(dst, b, h) do { _Pragma("unroll") for (int m = 0; m < 4; ++m) _Pragma("unroll") for (int k = 0; k < 2; ++k) dst[m][k] = *(const PG8_LAS bf16x8*)(lds + PG8_SA(b, h) + aoff + m * 2048 + k * 1024); } while (0)
#define PG8_LDB(dst, b, h) do { _Pragma("unroll") for (int n = 0; n < 2; ++n) _Pragma("unroll") for (int k = 0; k < 2; ++k) dst[n][k] = *(const PG8_LAS bf16x8*)(lds + PG8_SB(b, h) + boff + n * 2048 + k * 1024); } while (0)
#define PG8_MMA(ai, bj, At, Bt) do { __builtin_amdgcn_s_setprio(1); _Pragma("unroll") for (int m = 0; m < 4; ++m) _Pragma("unroll") for (int n = 0; n < 2; ++n) _Pragma("unroll") for (int k = 0; k < 2; ++k) \
        acc[ai][bj][m][n] = __builtin_amdgcn_mfma_f32_16x16x32_bf16(Bt[n][k], At[m][k], acc[ai][bj][m][n], 0, 0, 0); __builtin_amdgcn_s_setprio(0); } while (0)
#define PG8_WAIT_V(n) asm volatile("s_waitcnt vmcnt(" #n ")" ::: "memory")
#define PG8_WAIT_L(n) asm volatile("s_waitcnt lgkmcnt(" #n ")" ::: "memory")
#define PG8_BAR __builtin_amdgcn_s_barrier()
#define PG8_SCHED __builtin_amdgcn_sched_barrier(0)
    Unit cur, nxt; int ui = 0;
    if (!S.next(0, cur)) return;
    f32x4 acc[2][2][4][2];
#pragma unroll
    for (int a = 0; a < 2; ++a)
#pragma unroll
        for (int b = 0; b < 2; ++b)
#pragma unroll
            for (int m = 0; m < 4; ++m)
#pragma unroll
                for (int n = 0; n < 2; ++n) acc[a][b][m][n] = (f32x4){0.f, 0.f, 0.f, 0.f};
    bf16x8 At[4][2], B0[2][2], B1[2][2];
    const char* cA = (const char*)g.A + (size_t)cur.pm * tstep; const char* cB = (const char*)g.Bt + (size_t)cur.pn * tstep;
    S.a_ready(cur);
    if constexpr (SP2) {
        PG8_STAGE(PG8_SB(0, 0), cB, voffB); PG8_STAGE(PG8_SB(0, 1), cB + hstep, voffB); PG8_STAGE(PG8_SA(0, 0), cA, voffA); PG8_STAGE(PG8_SA(0, 1), cA + hstep, voffA);
        if (wr == 1) PG8_BAR;
        PG8_WAIT_V(2); PG8_BAR;
        PG8_STAGE(PG8_SB(1, 0), cB + kstep, voffB); PG8_STAGE(PG8_SA(1, 0), cA + kstep, voffA); PG8_STAGE(PG8_SB(1, 1), cB + hstep + kstep, voffB);
        PG8_WAIT_V(6); PG8_BAR;
    } else {
        PG8_STAGE(PG8_SB(0, 0), cB, voffB); PG8_STAGE(PG8_SA(0, 0), cA, voffA); PG8_STAGE(PG8_SB(0, 1), cB + hstep, voffB); PG8_STAGE(PG8_SA(0, 1), cA + hstep, voffA);
        if (wr == 1) PG8_BAR;
        PG8_WAIT_V(4); PG8_BAR;
        PG8_STAGE(PG8_SB(1, 0), cB + kstep, voffB); PG8_STAGE(PG8_SA(1, 0), cA + kstep, voffA); PG8_STAGE(PG8_SB(1, 1), cB + hstep + kstep, voffB);
        PG8_WAIT_V(6); PG8_BAR;
    }
    for (;;) {
        const bool has_next = S.next(ui + 1, nxt);
        const char* nA = has_next ? (const char*)g.A + (size_t)nxt.pm * tstep : cA; const char* nB = has_next ? (const char*)g.Bt + (size_t)nxt.pn * tstep : cB;
        for (int t = 0; t < nt; t += 2) {
            const bool last = (t == nt - 2);
            const char* a1 = cA + (size_t)(t + 1) * kstep;
            const char* a2 = last ? nA : cA + (size_t)(t + 2) * kstep; const char* b2 = last ? nB : cB + (size_t)(t + 2) * kstep;
            const char* a3 = a2 + kstep; const char* b3 = b2 + kstep;
            if (last && has_next) S.a_ready(nxt);
            if constexpr (SP2) {
            PG8_LDB(B0, 0, 0); PG8_LDB(B1, 0, 1); PG8_SCHED; PG8_LDA(At, 0, 0); PG8_STAGE(PG8_SA(1, 1), a1 + hstep, voffA);
            PG8_WAIT_V(8); PG8_WAIT_L(0); PG8_BAR; PG8_MMA(0, 0, At, B0); PG8_MMA(0, 1, At, B1); PG8_BAR; PG8_SCHED;
            PG8_LDA(At, 0, 1); PG8_STAGE(PG8_SB(0, 0), b2, voffB); PG8_STAGE(PG8_SB(0, 1), b2 + hstep, voffB); PG8_STAGE(PG8_SA(0, 0), a2, voffA);
            PG8_WAIT_V(8); PG8_WAIT_L(0); PG8_BAR; PG8_MMA(1, 0, At, B0); PG8_MMA(1, 1, At, B1); PG8_BAR; PG8_SCHED;
            PG8_LDB(B0, 1, 0); PG8_LDB(B1, 1, 1); PG8_SCHED; PG8_LDA(At, 1, 0); PG8_STAGE(PG8_SA(0, 1), a2 + hstep, voffA);
            PG8_WAIT_V(8); PG8_WAIT_L(0); PG8_BAR; PG8_MMA(0, 0, At, B0); PG8_MMA(0, 1, At, B1); PG8_BAR; PG8_SCHED;
            PG8_LDA(At, 1, 1); PG8_STAGE(PG8_SB(1, 0), b3, voffB); PG8_STAGE(PG8_SB(1, 1), b3 + hstep, voffB); PG8_STAGE(PG8_SA(1, 0), a3, voffA);
            PG8_WAIT_V(8); PG8_WAIT_L(0); PG8_BAR; PG8_MMA(1, 0, At, B0); PG8_MMA(1, 1, At, B1); PG8_BAR; PG8_SCHED;
            } else {
            PG8_LDB(B0, 0, 0); PG8_SCHED; PG8_LDA(At, 0, 0); PG8_STAGE(PG8_SA(1, 1), a1 + hstep, voffA);
            PG8_WAIT_L(8); PG8_BAR; PG8_WAIT_L(0); PG8_MMA(0, 0, At, B0); PG8_BAR; PG8_SCHED;
            PG8_LDB(B1, 0, 1); PG8_STAGE(PG8_SB(0, 0), b2, voffB);
            PG8_BAR; PG8_WAIT_L(0); PG8_MMA(0, 1, At, B1); PG8_BAR;
            PG8_LDA(At, 0, 1); PG8_STAGE(PG8_SA(0, 0), a2, voffA);
            PG8_BAR; PG8_WAIT_L(0); PG8_MMA(1, 0, At, B0); PG8_BAR; PG8_SCHED;
            PG8_STAGE(PG8_SB(0, 1), b2 + hstep, voffB);
            PG8_WAIT_V(6); PG8_BAR; PG8_MMA(1, 1, At, B1); PG8_BAR;
            PG8_LDB(B0, 1, 0); PG8_SCHED; PG8_LDA(At, 1, 0); PG8_STAGE(PG8_SA(0, 1), a2 + hstep, voffA);
            PG8_WAIT_L(8); PG8_BAR; PG8_WAIT_L(0); PG8_MMA(0, 0, At, B0); PG8_BAR; PG8_SCHED;
            PG8_LDB(B1, 1, 1); PG8_STAGE(PG8_SB(1, 0), b3, voffB);
            PG8_BAR; PG8_WAIT_L(0); PG8_MMA(0, 1, At, B1); PG8_BAR;
            PG8_LDA(At, 1, 1); PG8_STAGE(PG8_SA(1, 0), a3, voffA);
            PG8_BAR; PG8_WAIT_L(0); PG8_MMA(1, 0, At, B0); PG8_BAR; PG8_SCHED;
            PG8_STAGE(PG8_SB(1, 1), b3 + hstep, voffB);
            PG8_WAIT_V(6); PG8_BAR; PG8_MMA(1, 1, At, B1); PG8_BAR;
            }
        }
        if constexpr (ALIGN_EPI) { if (wr == 0) PG8_BAR; }
        if constexpr (!Epi::AFTER_DRAIN) { E(acc, cur, wr, wc, fr, fq); S.done(cur); }
        if (!has_next) break;
#pragma unroll
        for (int a = 0; a < 2; ++a)
#pragma unroll
            for (int b = 0; b < 2; ++b)
#pragma unroll
                for (int m = 0; m < 4; ++m)
#pragma unroll
                    for (int n = 0; n < 2; ++n) acc[a][b][m][n] = (f32x4){0.f, 0.f, 0.f, 0.f};
        cur = nxt; cA = nA; cB = nB; ++ui;
        if constexpr (ALIGN_EPI) { if (wr == 1) PG8_BAR; }
    }
    PG8_WAIT_V(0);
    if constexpr (!ALIGN_EPI) { if (wr == 0) PG8_BAR; }
    PG8_BAR;
    if constexpr (Epi::AFTER_DRAIN) { E.fused(acc, cur, wr, wc, fr, fq, lds, wid, lane); S.done(cur); }
#undef PG8_SA
#undef PG8_SB
#undef PG8_STAGE
#undef PG8_LDA
#undef PG8_LDB
#undef PG8_MMA
#undef PG8_WAIT_V
#undef PG8_WAIT_L
#undef PG8_BAR
#undef PG8_SCHED
}
}
#define GAS __attribute__((address_space(1)))
#define LAS __attribute__((address_space(3)))
typedef unsigned short bf16;
typedef unsigned v4u __attribute__((ext_vector_type(4)));
typedef float f32x4 __attribute__((ext_vector_type(4)));
typedef short bf16x8 __attribute__((ext_vector_type(8)));
typedef GAS unsigned gu32;
typedef GAS unsigned long long gu64;
#define RLX_AGENT __ATOMIC_RELAXED, __HIP_MEMORY_SCOPE_AGENT
#define LDS_WAIT() asm volatile("s_waitcnt lgkmcnt(0)" ::: "memory")
#define VM_WAIT() asm volatile("s_waitcnt vmcnt(0)" ::: "memory")
__device__ __forceinline__ unsigned long long rt() { return __builtin_amdgcn_s_memrealtime(); }
__device__ __forceinline__ unsigned f2bf(float f) { unsigned u = __builtin_bit_cast(unsigned, f); return (u + 0x7fffu + ((u >> 16) & 1u)) >> 16; }
__device__ __forceinline__ unsigned pk2(float lo, float hi) { return f2bf(lo) | (f2bf(hi) << 16); }

#define XB_TMO      128
#define XB_XCNT(j)  (256  + 64 * (j))
#define XB_XSUB(j)  (1280 + 64 * (j))
#define XB_XGEN(j)  (2304 + 64 * (j))
#define XB_TOP      3328
#define XB_TOPGEN   3392
#define XCD_BAR_WORDS 3456
#define XB_SPIN_CAP (1u << 18)

__device__ __forceinline__ unsigned xb_ld(unsigned* p)              { return __hip_atomic_load(p, __ATOMIC_RELAXED, __HIP_MEMORY_SCOPE_AGENT); }
__device__ __forceinline__ unsigned xb_add(unsigned* p, unsigned v) { return __hip_atomic_fetch_add(p, v, __ATOMIC_RELAXED, __HIP_MEMORY_SCOPE_AGENT); }
__device__ __forceinline__ unsigned xb_xcc_id() { return (unsigned)__builtin_amdgcn_s_getreg((3 << 11) | 20) & 0xFu; }
#define XB_SPIN(cond, bar) do { unsigned _sp = 0; while (cond) { __builtin_amdgcn_s_sleep(1); \
    if ((++_sp & 255u) == 0u) { if (xb_ld(&(bar)[XB_TMO])) break; if (_sp > XB_SPIN_CAP) { atomicAdd(&(bar)[XB_TMO], 1u); break; } } } } while (0)

struct XcdBarrier {
    unsigned* bar; unsigned x; int wave;
    volatile LAS unsigned* st;
};

__device__ __forceinline__ XcdBarrier xcd_barrier_post(unsigned* bar, volatile LAS unsigned* st) {
    XcdBarrier b; b.bar = bar; b.x = xb_xcc_id(); b.st = st;
    if (threadIdx.x == 0) (void)xb_add(&bar[XB_XCNT(b.x)], 1u);
    return b;
}
__device__ __forceinline__ void xcd_barrier_complete(unsigned* bar, unsigned x, unsigned& nloc, unsigned& nx) {
    const unsigned G = gridDim.x * gridDim.y * gridDim.z;
    unsigned sum, cnt, mine, sp = 0u;
    for (;;) {
        sum = 0u; cnt = 0u; mine = 0u;
#pragma unroll
        for (unsigned j = 0; j < 16; ++j) { const unsigned c = xb_ld(&bar[XB_XCNT(j)]); sum += c; cnt += (c > 0u) ? 1u : 0u; mine = (j == x) ? c : mine; }
        if (sum == G) break;
        __builtin_amdgcn_s_sleep(1);
        if ((++sp & 255u) == 0u) { if (xb_ld(&bar[XB_TMO])) break; if (sp > XB_SPIN_CAP) { atomicAdd(&bar[XB_TMO], 1u); break; } }
    }
    nloc = mine > 0u ? mine : 1u; nx = cnt > 0u ? cnt : 1u;
}

__device__ __forceinline__ void xcd_barrier(const XcdBarrier& b) {
    asm volatile("s_waitcnt vmcnt(0)" ::: "memory");
    __syncthreads();
    if (b.wave == 0 && __builtin_amdgcn_mbcnt_hi(~0u, __builtin_amdgcn_mbcnt_lo(~0u, 0u)) == 0u) {
        unsigned* bar = b.bar;
        __builtin_amdgcn_s_waitcnt(0);
        unsigned nloc = b.st[0], nx = b.st[1];
        if (nloc == 0u) { xcd_barrier_complete(bar, b.x, nloc, nx); b.st[0] = nloc; b.st[1] = nx; }
        const unsigned old = xb_add(&bar[XB_XSUB(b.x)], 1u);
        const unsigned gen = old / nloc;
        if (old + 1u == (gen + 1u) * nloc) {
            __builtin_amdgcn_fence(__ATOMIC_RELEASE, "agent");
            asm volatile("s_waitcnt vmcnt(0)" ::: "memory");
            const unsigned og = xb_add(&bar[XB_TOP], 1u);
            const unsigned tg = og / nx;
            if (og + 1u == (tg + 1u) * nx) xb_add(&bar[XB_TOPGEN], 1u);
            else XB_SPIN(xb_ld(&bar[XB_TOPGEN]) == tg, bar);
            __builtin_amdgcn_fence(__ATOMIC_ACQUIRE, "agent");
            xb_add(&bar[XB_XGEN(b.x)], 1u);
            asm volatile("s_waitcnt vmcnt(0)" ::: "memory");
        } else {
            XB_SPIN(xb_ld(&bar[XB_XGEN(b.x)]) == gen, bar);
            __builtin_amdgcn_fence(__ATOMIC_ACQUIRE, "agent");
            asm volatile("s_waitcnt vmcnt(0)" ::: "memory");
        }
    }
    __syncthreads();
}
namespace mk {
constexpr int S = 16384, DM = 1024, NIN = 3008, NINP = 3072, NWAVES = 8;
constexpr float RMS_EPS = 1e-6f, LOG2E = 1.4426950408889634f;
constexpr float DIFF_C = 0.125f * LOG2E;
constexpr float MLA_C = 0.07216878364870323f * LOG2E;
constexpr size_t MiB = 1u << 20;
constexpr size_t WS_CTL = 0, CTL_ZERO_BYTES = 1 * MiB;
constexpr size_t WS_MODP = 1 * MiB;
constexpr size_t WS_MODF = 1 * MiB + 512 * 1024;
constexpr size_t WS_BT1 = 2 * MiB, WS_BT3 = 8 * MiB;
constexpr size_t WS_WUQT = 10 * MiB, WS_WUKT = 10 * MiB + 512 * 1024, WS_WUVT = 10 * MiB + 768 * 1024;
constexpr size_t WS_XN = 12 * MiB;
constexpr size_t WS_DQ = 44 * MiB, WS_DK = 60 * MiB, WS_DV = 76 * MiB;
constexpr size_t WS_CQ = 92 * MiB, WS_CKV = 108 * MiB, WS_KR = 116 * MiB;
constexpr size_t WS_SG = 120 * MiB;
constexpr size_t WS_QM = 152 * MiB, WS_KM = 176 * MiB, WS_VM = 200 * MiB;
constexpr size_t WS_ROPE = 216 * MiB;
constexpr size_t WS_END = 220 * MiB;
constexpr int CW_BAR = 4096;
constexpr int CW_QUEUE = 16384;
#ifndef FUSE_P3
#define FUSE_P3 1
#endif
constexpr int CW_DONE = 18432;
constexpr int CW_P3Q = 19968;
constexpr int RING_BYTES = 131072, LDSCTL_OFF = 160 * 1024 - 512, MISC_OFF = LDSCTL_OFF + 320, LDS_BYTES = 160 * 1024;

typedef float f32x16 __attribute__((ext_vector_type(16)));
typedef short s16x4 __attribute__((ext_vector_type(4)));
typedef unsigned u32x2 __attribute__((ext_vector_type(2)));

struct Args { const void* in[20]; float* out; unsigned char* ws; int ph_lo, ph_hi, li, pad; };

__device__ __forceinline__ unsigned cvtpk(float lo, float hi) { unsigned r; asm volatile("v_cvt_pk_bf16_f32 %0, %1, %2" : "=v"(r) : "v"(lo), "v"(hi)); return r; }
__device__ __forceinline__ float bf2f(unsigned short b) { return __uint_as_float((unsigned)b << 16); }
__device__ __forceinline__ float silu_f(float v) { return v / (1.f + __expf(-v)); }
__device__ __forceinline__ float silu_g(float v) { return v * __builtin_amdgcn_rcpf(1.f + __builtin_amdgcn_exp2f(v * -1.4426950408889634f)); }
__device__ __forceinline__ float wave_sum(float v) {
#pragma unroll
    for (int o = 1; o < 64; o <<= 1) v += __shfl_xor(v, o);
    return v;
}
__device__ __forceinline__ float half_swap_add(float v) {
    auto rr = __builtin_amdgcn_permlane32_swap(__float_as_uint(v), __float_as_uint(v), false, false);
    return __uint_as_float(rr[0]) + __uint_as_float(rr[1]);
}
__device__ __forceinline__ int crow(int r, int hi) { return (r & 3) + 8 * (r >> 2) + 4 * hi; }
__host__ __device__ __forceinline__ int rowperm(int n) {
    const int pn = n >> 8, q = n & 255, wc = q >> 6, j = q & 63, bj = j >> 5, fq = (j >> 3) & 3, nn = (j >> 2) & 1, e = j & 3;
    return (pn << 8) + 128 * bj + 32 * wc + 16 * nn + 4 * fq + e;
}
__host__ __device__ __forceinline__ int rowperm3(int n) {
    const int pn = n >> 8, q = n & 255, wc = q >> 6, j = q & 63, bj = j >> 5, nn = (j >> 4) & 1, fq = (j >> 2) & 3, e = j & 3;
    return (pn << 8) + 128 * bj + 32 * wc + 16 * nn + 4 * fq + e;
}
__device__ const double INVF[32] = {1.0, 0.7498942093324559, 0.5623413251903491, 0.4216965034285822, 0.31622776601683794, 0.23713737056616552, 0.1778279410038923, 0.1333521432163324, 0.1, 0.07498942093324558, 0.05623413251903491, 0.042169650342858224, 0.03162277660168379, 0.023713737056616554, 0.01778279410038923, 0.01333521432163324, 0.01, 0.007498942093324558, 0.005623413251903491, 0.004216965034285823, 0.0031622776601683794, 0.0023713737056616554, 0.0017782794100389228, 0.001333521432163324, 0.001, 0.0007498942093324559, 0.0005623413251903491, 0.00042169650342858224, 0.00031622776601683794, 0.00023713737056616554, 0.00017782794100389227, 0.0001333521432163324};
__device__ __forceinline__ void rope_cs(float fpos, int i, float& cs, float& sn) {
    const float ang = fpos * (float)INVF[i];
    double t = (double)ang * 0.15915494309189535; t -= __builtin_rint(t);
    const float tf = (float)t; cs = __builtin_amdgcn_cosf(tf); sn = __builtin_amdgcn_sinf(tf);
}
__device__ __forceinline__ int t5_bucket(int rel) {
    const int n = rel < 0 ? -rel : rel; int b;
    if (n < 8) b = n; else { const unsigned n2 = (unsigned)n * (unsigned)n; b = 8 + (31 - __builtin_clz(n2 >> 6)); if (b > 15) b = 15; }
    return (rel > 0 ? 16 : 0) + b;
}

struct Frame {
    LAS unsigned char* lds; volatile LAS unsigned* MISC; gu32* ctl;
    int tid, lane, wave, vcu, G;
    const float *x, *c, *rel_bias, *ada_w, *ada_b, *norm_g, *w_in, *dqn, *dkn, *dlam, *dsub, *qan, *kvan, *w_uq, *w_uk, *w_uv, *mqn, *mkn, *w_out; const int* pos;
    float* out; unsigned char* ws;
    float *MODP, *MODF, *ROPE; bf16 *CQ, *CKV, *KR; bf16 *BT1, *BT3, *WUQT, *WUKT, *WUVT, *XN, *A3, *DQ, *DK, *DV, *SG, *QM, *KM, *VM;
};

template <int PERM>
__device__ __forceinline__ void p0_transpose_item(const float* W, int K, int N, bf16* WT, LAS float* scr, int item, int lane) {
    const int nblk = N / 32, kb = item / nblk, nb = item % nblk, k0 = 64 * kb, n0 = 32 * nb;
    { f32x4 w[8];
#pragma unroll
      for (int i = 0; i < 8; ++i) { const int kk = 8 * i + (lane >> 3); w[i] = *(const GAS f32x4*)(W + (size_t)(k0 + kk) * N + n0 + 4 * (lane & 7)); }
#pragma unroll
      for (int i = 0; i < 8; ++i) { LAS float* d = scr + (8 * i + (lane >> 3)) * 33 + 4 * (lane & 7); d[0] = w[i].x; d[1] = w[i].y; d[2] = w[i].z; d[3] = w[i].w; } }
    LDS_WAIT(); asm volatile("" ::: "memory");
    const int c = lane & 7;
#pragma unroll
    for (int j = 0; j < 4; ++j) { const int n = (lane >> 3) + 8 * j; const LAS float* s = scr + (8 * c) * 33 + n;
        v4u o; o.x = pk2(s[0 * 33], s[1 * 33]); o.y = pk2(s[2 * 33], s[3 * 33]); o.z = pk2(s[4 * 33], s[5 * 33]); o.w = pk2(s[6 * 33], s[7 * 33]);
        const int row = PERM == 1 ? rowperm(n0 + n) : (PERM == 2 ? rowperm3(n0 + n) : (n0 + n));
        *(GAS v4u*)(WT + (size_t)row * K + k0 + 8 * c) = o; }
    LDS_WAIT(); asm volatile("" ::: "memory");
}
__device__ const unsigned short ATT_ORD[768] = {63,319,575,831,62,318,574,830,61,317,573,829,60,316,572,828,59,315,571,827,58,314,570,826,57,313,569,825,56,312,568,824,55,311,567,823,54,310,566,822,53,309,565,821,52,308,564,820,51,307,563,819,50,306,562,818,49,305,561,817,48,304,560,816,47,303,559,815,46,302,558,814,45,301,557,813,44,300,556,812,43,299,555,811,32895,33151,33407,33663,42,298,554,810,32894,33150,33406,33662,32893,33149,33405,33661,32892,33148,33404,33660,41,297,553,809,32891,33147,33403,33659,32890,33146,33402,33658,32889,33145,33401,33657,40,296,552,808,32888,33144,33400,33656,32887,33143,33399,33655,32886,33142,33398,33654,39,295,551,807,32885,33141,33397,33653,32884,33140,33396,33652,32883,33139,33395,33651,38,294,550,806,32882,33138,33394,33650,32867,33379,32866,33378,32,544,32864,33376,32863,33375,32862,33374,32861,33373,32860,33372,32859,33371,32858,33370,32857,33369,32856,33368,32855,33367,32854,33366,32853,33365,32852,33364,32851,33363,32850,33362,32849,33361,26,538,32847,33359,32846,33358,25,537,32844,33356,32843,33355,24,792,32840,33608,33350,33093,22,790,32834,33602,33344,33087,20,788,32828,33596,32826,33594,18,786,32822,785,33331,528,32816,783,33582,526,32810,33064,268,32804,267,33313,10,33054,32796,33306,33561,263,33557,33299,517,260,771,33286,33542,33290,516,33029,773,33555,33300,519,33048,33546,33285,33562,33052,33310,266,772,33569,523,33541,33060,524,33296,33033,33320,33066,32786,782,1,33556,33325,32814,33072,784,775,33037,33587,33076,33289,33304,257,33078,274,33335,8,33082,33337,33552,33084,531,33308,276,33341,33343,513,33600,33566,33042,33090,32832,33545,278,33347,522,33293,33349,6,33606,32800,33096,32838,769,280,33353,779,33099,33611,33100,33612,281,793,33316,33046,33102,33614,32783,33103,33615,282,794,780,32776,33105,33617,33560,33106,33618,33028,33107,33619,33108,33620,33576,33109,33621,33549,33110,33622,264,33111,33623,33298,33112,33624,33322,33113,33625,33114,33626,33284,33115,33627,33323,33116,33628,33032,33564,33117,33629,33118,33630,262,33119,33631,33581,33120,33632,33070,288,800,33122,33634,33039,9,33540,33123,33635,33328,32780,33329,33302,778,33288,16,33056,32771,33332,33554,33047,33334,33058,32881,33137,33393,33649,33027,37,293,549,805,33591,32880,33136,33392,33648,530,32879,33135,33391,33647,520,33572,32878,33134,33390,33646,33544,33295,36,292,548,804,32877,33133,33389,33645,518,32876,33132,33388,33644,33036,33593,32875,33131,33387,33643,33338,35,291,547,803,32874,33130,33386,33642,33317,32873,33129,33385,33641,33283,787,32872,33128,33384,33640,34,290,546,802,32871,33127,33383,33639,33340,32870,33126,33382,33638,33563,32869,33125,33381,33637,33,289,545,801,33597,32868,33124,33380,33636,532,33319,33539,2,32865,33121,33377,33633,33558,33599,265,33297,32831,31,287,543,799,33088,33578,33292,30,286,542,798,33346,33026,33551,33303,29,285,541,797,33603,33579,534,33311,28,284,540,796,258,33605,774,33312,33282,32837,27,283,539,795,270,33094,776,33326,32848,33104,33360,33616,33352,33538,32845,33101,33357,33613,33609,536,33314,33548,33584,32842,33098,33354,33610,33553,514,32841,33097,0,33045,33351,33607,535,791,32839,33095,33038,32794,33585,23,279,33571,32836,33092,33348,33604,272,32835,33091,33345,33601,533,789,32833,33089,256,21,277,33573,521,33559,33588,32830,33086,33342,33598,32829,33085,770,32787,33547,33339,33595,19,275,32827,33083,512,32825,33081,33590,32824,33080,33336,33592,33575,32823,33079,33589,17,273,529,33333,32821,33077,5,33294,32820,768,33567,32819,33075,33305,32818,33074,33330,33586,32817,33073,33031,33568,33327,33583,271,527,32815,33071,15,32808,33025,33301,32813,33069,14,32812,33068,33324,33580,3,32811,33067,781,33577,13,269,525,33321,32809,33065,33281,33050,32807,33063,12,32806,33062,33318,33574,33570,33043,33287,32805,33061,33315,32803,33059,33537,7,11,32802,33550,32801,33057,261,32799,33055,32798,33565,33309,32768,777,32797,33053,259,33307,32795,33051,33543,33024,32793,33049,32792,32791,32790,32789,33280,33044,32788,33041,32785,33040,32784,33536,4,33030,32782,32781,515,33291,33035,32779,33034,32778,32777,32775,32774,32773,32772,32770,32769};
#ifndef LPT_D
#define LPT_D 6
#define LPT_M 26
#endif
__device__ __forceinline__ void p0_prologue(Frame& F) {
    LAS float* scr = (LAS float*)(F.lds + F.wave * 16384);
    const int gw = F.wave * F.G + F.vcu, NGW = F.G * NWAVES, lane = F.lane;
    constexpr int I_IN = (DM / 64) * (NIN / 32), I_OUT = (DM / 64) * (DM / 32), I_UQ = (256 / 64) * (768 / 32), I_UK = (128 / 64) * (512 / 32), I_UV = I_UK;
    constexpr int I_GEMV = 16 * 12, I_PAD = 64, I_TR = I_IN + I_OUT + I_UQ + I_UK + I_UV;
    constexpr int NITEMS = I_TR + I_GEMV + I_PAD + 1;
    int gp0 = NITEMS - NGW; gp0 = gp0 < 0 ? 0 : (gp0 > NITEMS - I_GEMV ? NITEMS - I_GEMV : gp0);
    for (int it = gw; it < NITEMS; it += NGW) {
        int r; if (it >= gp0 && it < gp0 + I_GEMV) r = I_TR + (it - gp0); else { const int q = it < gp0 ? it : it - I_GEMV; r = q < I_TR ? q : q + I_GEMV; }
        if (r < I_IN) { p0_transpose_item<1>(F.w_in, DM, NIN, F.BT1, scr, r, lane); continue; } r -= I_IN;
        if (r < I_OUT) { p0_transpose_item<2>(F.w_out, DM, DM, F.BT3, scr, r, lane); continue; } r -= I_OUT;
        if (r < I_UQ) { p0_transpose_item<0>(F.w_uq, 256, 768, F.WUQT, scr, r, lane); continue; } r -= I_UQ;
        if (r < I_UK) { p0_transpose_item<0>(F.w_uk, 128, 512, F.WUKT, scr, r, lane); continue; } r -= I_UK;
        if (r < I_UV) { p0_transpose_item<0>(F.w_uv, 128, 512, F.WUVT, scr, r, lane); continue; } r -= I_UV;
        if (r < I_GEMV) {
            const int kq = r / 12, cg = r % 12; const GAS f32x4* wp = (const GAS f32x4*)(F.ada_w + (size_t)(64 * kq) * 3072 + 256 * cg) + lane;
            f32x4 acc = {0.f, 0.f, 0.f, 0.f};
            const int sl = __float_as_int(silu_f(F.c[64 * kq + lane]));
#pragma unroll
            for (int b = 0; b < 2; ++b) { f32x4 w[32];
#pragma unroll
                for (int k = 0; k < 32; ++k) w[k] = wp[(size_t)(32 * b + k) * 768];
#pragma unroll
                for (int k = 0; k < 32; ++k) acc += w[k] * __int_as_float(__builtin_amdgcn_readlane(sl, 32 * b + k)); }
            *((GAS f32x4*)(F.MODP + kq * 3072 + 256 * cg) + lane) = acc; continue; } r -= I_GEMV;
        if (r < I_PAD) { GAS v4u* p = (GAS v4u*)(F.BT1 + (size_t)rowperm(NIN + r) * DM) + 2 * lane; const v4u z = {0u, 0u, 0u, 0u}; p[0] = z; p[1] = z; continue; } r -= I_PAD;
        { unsigned short* ord = (unsigned short*)(F.MODF + 4096);
          for (int u = lane; u < 768; u += 64) ord[u] = ATT_ORD[u]; }
        if (lane == 0) { float a = 0.f, b = 0.f; for (int d = 0; d < 64; ++d) { a += F.dlam[d] * F.dlam[64 + d]; b += F.dlam[128 + d] * F.dlam[192 + d]; }
            F.MODF[3072] = expf(a) - expf(b) + 0.2f; }
    }
}
__device__ __forceinline__ void p0_rope_table(Frame& F) {
    const int gt = (F.vcu * NWAVES + F.wave) * 64 + F.lane, NT_ = F.G * NWAVES * 64;
    for (int e = gt; e < S * 32; e += NT_) { const int row = e >> 5, i = e & 31; float cs, sn; rope_cs((float)F.pos[row], i, cs, sn); F.ROPE[(size_t)row * 64 + i] = cs; F.ROPE[(size_t)row * 64 + 32 + i] = sn; }
}
__device__ __forceinline__ void p0b_xn(Frame& F) {
    LAS float* modL = (LAS float*)F.lds;
    { const int t = F.tid; f32x4 v = *(const GAS f32x4*)(F.ada_b + 4 * t);
#pragma unroll
      for (int kq = 0; kq < 16; ++kq) v += *(const GAS f32x4*)(F.MODP + kq * 3072 + 4 * t);
      *(LAS f32x4*)(modL + 4 * t) = v;
      if (blockIdx.x == 0 && t < 256) { f32x4 g = *(const GAS f32x4*)(F.ada_b + 2048 + 4 * t);
#pragma unroll
          for (int kq = 0; kq < 16; ++kq) g += *(const GAS f32x4*)(F.MODP + kq * 3072 + 2048 + 4 * t);
          *(GAS f32x4*)(F.MODF + 2048 + 4 * t) = g; } }
    __syncthreads();
    f32x4 a[4], sh[4];
#pragma unroll
    for (int j = 0; j < 4; ++j) { const int k = 4 * F.lane + 256 * j; const f32x4 g = *(const GAS f32x4*)(F.norm_g + k); const f32x4 sc = *(LAS f32x4*)(modL + 1024 + k);
        a[j] = g * (sc + 1.f); sh[j] = *(LAS f32x4*)(modL + k); }
    const int gw = F.vcu * NWAVES + F.wave, NGW = F.G * NWAVES;
    f32x4 v[4], u[4];
    if (gw < S) { const int m2 = (gw + NGW < S) ? gw + NGW : gw;
#pragma unroll
        for (int j = 0; j < 4; ++j) { v[j] = ((const GAS f32x4*)(F.x + (size_t)gw * DM) + F.lane)[64 * j]; u[j] = ((const GAS f32x4*)(F.x + (size_t)m2 * DM) + F.lane)[64 * j]; } }
    for (int m = gw; m < S; m += 2 * NGW) {
        const int m2 = (m + NGW < S) ? m + NGW : m;
        float s = 0.f, s2 = 0.f;
#pragma unroll
        for (int j = 0; j < 4; ++j) { s += (v[j].x * v[j].x + v[j].y * v[j].y) + (v[j].z * v[j].z + v[j].w * v[j].w); s2 += (u[j].x * u[j].x + u[j].y * u[j].y) + (u[j].z * u[j].z + u[j].w * u[j].w); }
        const float rinv = rsqrtf(wave_sum(s) * (1.f / DM) + RMS_EPS), rinv2 = rsqrtf(wave_sum(s2) * (1.f / DM) + RMS_EPS);
        f32x4 vn[4], un[4]; const int mn = m + 2 * NGW;
        if (mn < S) { const int mn2 = (mn + NGW < S) ? mn + NGW : mn;
#pragma unroll
            for (int j = 0; j < 4; ++j) { vn[j] = ((const GAS f32x4*)(F.x + (size_t)mn * DM) + F.lane)[64 * j]; un[j] = ((const GAS f32x4*)(F.x + (size_t)mn2 * DM) + F.lane)[64 * j]; } }
        __builtin_amdgcn_sched_barrier(0);
        GAS u32x2* o8 = (GAS u32x2*)(F.XN + (size_t)m * DM) + F.lane; GAS u32x2* o82 = (GAS u32x2*)(F.XN + (size_t)m2 * DM) + F.lane;
#pragma unroll
        for (int j = 0; j < 4; ++j) { const f32x4 o = v[j] * rinv * a[j] + sh[j]; u32x2 w; w.x = cvtpk(o.x, o.y); w.y = cvtpk(o.z, o.w); o8[64 * j] = w;
            const f32x4 o2 = u[j] * rinv2 * a[j] + sh[j]; u32x2 w2; w2.x = cvtpk(o2.x, o2.y); w2.y = cvtpk(o2.z, o2.w); o82[64 * j] = w2; }
#pragma unroll
        for (int j = 0; j < 4; ++j) { v[j] = vn[j]; u[j] = un[j]; }
    }
    __syncthreads();
}
struct Epi1 {
    static constexpr bool PERM = false, AFTER_DRAIN = false;
    bf16 *DQ, *DK, *DV, *SG, *CQ, *CKV, *KR; const float *gq, *gk;
    __device__ __forceinline__ void operator()(const f32x4 (&acc)[2][2][4][2], const pg8::Unit& u, int wr, int wc, int fr, int fq) const {
        const int G = u.pn * 4 + wc, rowb = u.pm * 256 + wr * 64 + fr, c8 = 8 * fq;
        if (G < 16) {
            const bool isq = G < 8; const int g8 = G & 7, h = g8 >> 1, c = g8 & 1; const float* gain = isq ? gq : gk;
            bf16* dst = (isq ? DQ : DK) + (size_t)h * S * 128 + 64 * c + c8; const float mul = isq ? DIFF_C : 1.f;
            f32x4 gv[2][2];
#pragma unroll
            for (int bj = 0; bj < 2; ++bj)
#pragma unroll
                for (int n = 0; n < 2; ++n) gv[bj][n] = *(const GAS f32x4*)(gain + 32 * bj + c8 + 4 * n);
#pragma unroll
            for (int ai = 0; ai < 2; ++ai)
#pragma unroll
                for (int m = 0; m < 4; ++m) {
                    float s = 0.f;
#pragma unroll
                    for (int bj = 0; bj < 2; ++bj)
#pragma unroll
                        for (int n = 0; n < 2; ++n) { const f32x4 v = acc[ai][bj][m][n]; s += (v.x * v.x + v.y * v.y) + (v.z * v.z + v.w * v.w); }
                    s += __shfl_xor(s, 16); s += __shfl_xor(s, 32);
                    const float rinv = rsqrtf(s * (1.f / 64.f) + RMS_EPS) * mul;
                    bf16* rp = dst + (size_t)(rowb + 128 * ai + 16 * m) * 128;
#pragma unroll
                    for (int bj = 0; bj < 2; ++bj) { const f32x4 v0 = acc[ai][bj][m][0] * rinv * gv[bj][0], v1 = acc[ai][bj][m][1] * rinv * gv[bj][1];
                        v4u w; w.x = cvtpk(v0.x, v0.y); w.y = cvtpk(v0.z, v0.w); w.z = cvtpk(v1.x, v1.y); w.w = cvtpk(v1.z, v1.w); *(GAS v4u*)(rp + 32 * bj) = w; }
                }
        } else if (G < 24 || (G >= 31 && G < 47)) {
            const bool isv = G < 24; bf16* dst; int ld;
            if (isv) { const int h = (G - 16) >> 1, half = (G - 16) & 1; dst = DV + (size_t)h * S * 128 + 64 * half + c8; ld = 128; }
            else { dst = SG + 64 * (G - 31) + c8; ld = 1024; }
#pragma unroll
            for (int ai = 0; ai < 2; ++ai)
#pragma unroll
                for (int m = 0; m < 4; ++m) { bf16* rp = dst + (size_t)(rowb + 128 * ai + 16 * m) * ld;
#pragma unroll
                    for (int bj = 0; bj < 2; ++bj) { f32x4 v0 = acc[ai][bj][m][0], v1 = acc[ai][bj][m][1];
                        if (!isv) { v0.x = silu_g(v0.x); v0.y = silu_g(v0.y); v0.z = silu_g(v0.z); v0.w = silu_g(v0.w); v1.x = silu_g(v1.x); v1.y = silu_g(v1.y); v1.z = silu_g(v1.z); v1.w = silu_g(v1.w); }
                        v4u w; w.x = cvtpk(v0.x, v0.y); w.y = cvtpk(v0.z, v0.w); w.z = cvtpk(v1.x, v1.y); w.w = cvtpk(v1.z, v1.w); *(GAS v4u*)(rp + 32 * bj) = w; } }
        } else if (G < 31) {
            bf16* dst; int ld;
            if (G < 28) { dst = CQ + 64 * (G - 24) + c8; ld = 256; } else if (G < 30) { dst = CKV + 64 * (G - 28) + c8; ld = 128; } else { dst = KR + c8; ld = 64; }
#pragma unroll
            for (int ai = 0; ai < 2; ++ai)
#pragma unroll
                for (int m = 0; m < 4; ++m) { bf16* rp = dst + (size_t)(rowb + 128 * ai + 16 * m) * ld;
#pragma unroll
                    for (int bj = 0; bj < 2; ++bj) { const f32x4 v0 = acc[ai][bj][m][0], v1 = acc[ai][bj][m][1];
                        v4u w; w.x = cvtpk(v0.x, v0.y); w.y = cvtpk(v0.z, v0.w); w.z = cvtpk(v1.x, v1.y); w.w = cvtpk(v1.z, v1.w); *(GAS v4u*)(rp + 32 * bj) = w; } }
        }
    }
};
#ifndef TS_DET
#define TS_DET 0
#endif
struct Epi3 {
    static constexpr bool PERM = false, AFTER_DRAIN = false;
    const float* x; float* out; const float* gate;
    __device__ __forceinline__ void operator()(const f32x4 (&acc)[2][2][4][2], const pg8::Unit& u, int wr, int wc, int fr, int fq) const {
        const int rowb = u.pm * 256 + wr * 64 + fr, col0 = u.pn * 256 + 64 * wc + 4 * fq;
        f32x4 gv[2][2];
#pragma unroll
        for (int bj = 0; bj < 2; ++bj)
#pragma unroll
            for (int n = 0; n < 2; ++n) gv[bj][n] = *(const GAS f32x4*)(gate + col0 + 32 * bj + 16 * n);
#pragma unroll
        for (int ai = 0; ai < 2; ++ai) {
            f32x4 xv[4][2][2];
#pragma unroll
            for (int m = 0; m < 4; ++m) { const size_t off = (size_t)(rowb + 128 * ai + 16 * m) * DM + col0;
#pragma unroll
                for (int bj = 0; bj < 2; ++bj)
#pragma unroll
                    for (int n = 0; n < 2; ++n) xv[m][bj][n] = *(const GAS f32x4*)(x + off + 32 * bj + 16 * n); }
            __builtin_amdgcn_sched_barrier(0);
#pragma unroll
            for (int m = 0; m < 4; ++m) { const size_t off = (size_t)(rowb + 128 * ai + 16 * m) * DM + col0;
#pragma unroll
                for (int bj = 0; bj < 2; ++bj)
#pragma unroll
                    for (int n = 0; n < 2; ++n) *(GAS f32x4*)(out + off + 32 * bj + 16 * n) = TS_DET ? xv[m][bj][n] : (xv[m][bj][n] + gv[bj][n] * acc[ai][bj][m][n]); }
            __builtin_amdgcn_sched_barrier(0);
        }
    }
};
template <int KB> __device__ __forceinline__ void stage_w_dma(const bf16* src, LAS unsigned char* dst, int nrows, int wave, int lane) {
    constexpr int CPR = KB / 16; const int npieces = nrows * CPR / 64;
    for (int pc = wave; pc < npieces; pc += NWAVES) { const int p = pc * 64 + lane, row = p / CPR, ch = (p % CPR) ^ (row & 15);
        __builtin_amdgcn_global_load_lds((const GAS unsigned*)((const char*)src + (size_t)row * KB + ch * 16), (LAS unsigned*)(dst + pc * 1024), 16, 0, 0); }
}
template <int KSTEPS, int KB> __device__ __forceinline__ void rowown_mma(f32x16& acc, const char* wl, int cb, const bf16x8* xf, int r32, int hi) {
    const char* rp = wl + (32 * cb + r32) * KB;
#pragma unroll
    for (int s = 0; s < KSTEPS; ++s) { const bf16x8 a = *(const bf16x8*)(rp + (((2 * s + hi) ^ (r32 & 15)) << 4)); acc = __builtin_amdgcn_mfma_f32_32x32x16_bf16(a, xf[s], acc, 0, 0, 0); }
}
__device__ __forceinline__ void store_chunk64(const f32x16& a0, const f32x16& a1, char* stg, bf16* dst_row0, int ld, int r32, int hi, int lane) {
#pragma unroll
    for (int g = 0; g < 4; ++g) { u32x2 w0, w1; w0.x = cvtpk(a0[4 * g], a0[4 * g + 1]); w0.y = cvtpk(a0[4 * g + 2], a0[4 * g + 3]); w1.x = cvtpk(a1[4 * g], a1[4 * g + 1]); w1.y = cvtpk(a1[4 * g + 2], a1[4 * g + 3]);
        *(u32x2*)(stg + r32 * 128 + (8 * g + 4 * hi) * 2) = w0; *(u32x2*)(stg + r32 * 128 + (32 + 8 * g + 4 * hi) * 2) = w1; }
    asm volatile("s_waitcnt lgkmcnt(0)" ::: "memory");
    v4u vs[4];
#pragma unroll
    for (int i = 0; i < 4; ++i) { const int row = 8 * i + (lane >> 3), ch = lane & 7; vs[i] = *(const LAS v4u*)(unsigned)(uintptr_t)(stg + row * 128 + ch * 16); }
    asm volatile("s_waitcnt lgkmcnt(0)" ::: "memory");
#pragma unroll
    for (int i = 0; i < 4; ++i) { const int row = 8 * i + (lane >> 3), ch = lane & 7; *(GAS v4u*)(dst_row0 + (size_t)row * ld + 8 * ch) = vs[i]; }
    asm volatile("s_waitcnt lgkmcnt(0)" ::: "memory");
}
#ifndef TS_SEL
#define TS_SEL 0
#endif
#define P1B_STAMP(F, k) do { if (TS_SEL == 10 && F.wave == 0 && __builtin_amdgcn_mbcnt_hi(~0u, __builtin_amdgcn_mbcnt_lo(~0u, 0u)) == 0u) { ((volatile LAS unsigned long long*)(F.lds + MISC_OFF + 64))[k] = __builtin_amdgcn_s_memrealtime(); } } while (0)
template <int NCB, int KSTEPS, int KB> __device__ __forceinline__ void rowown_mma_all(f32x16 (&acc)[NCB], const char* wl, const bf16x8* xf, int r32, int hi) {
    const char* rp = wl + r32 * KB; const int xr = r32 & 15;
    bf16x8 fa[NCB], fb[NCB];
#pragma unroll
    for (int cb = 0; cb < NCB; ++cb) { acc[cb] = f32x16{}; fa[cb] = *(const bf16x8*)(rp + cb * 32 * KB + (((0 + hi) ^ xr) << 4)); }
#pragma unroll
    for (int s = 0; s < KSTEPS; s += 2) {
#pragma unroll
        for (int cb = 0; cb < NCB; ++cb) fb[cb] = *(const bf16x8*)(rp + cb * 32 * KB + (((2 * (s + 1) + hi) ^ xr) << 4));
        __builtin_amdgcn_sched_barrier(0);
#pragma unroll
        for (int cb = 0; cb < NCB; ++cb) acc[cb] = __builtin_amdgcn_mfma_f32_32x32x16_bf16(fa[cb], xf[s], acc[cb], 0, 0, 0);
        __builtin_amdgcn_sched_barrier(0);
        if (s + 2 < KSTEPS) {
#pragma unroll
            for (int cb = 0; cb < NCB; ++cb) fa[cb] = *(const bf16x8*)(rp + cb * 32 * KB + (((2 * (s + 2) + hi) ^ xr) << 4));
        }
        __builtin_amdgcn_sched_barrier(0);
#pragma unroll
        for (int cb = 0; cb < NCB; ++cb) acc[cb] = __builtin_amdgcn_mfma_f32_32x32x16_bf16(fb[cb], xf[s + 1], acc[cb], 0, 0, 0);
        __builtin_amdgcn_sched_barrier(0);
    }
}
template <bool PREFETCHED> __device__ __forceinline__ void p1b_q_unit(Frame& F, int rb, int h, char* lds) {
    int lane_o = (int)__builtin_amdgcn_mbcnt_hi(~0u, __builtin_amdgcn_mbcnt_lo(~0u, 0u)); asm volatile("" : "+v"(lane_o));
    const int lane = lane_o, r32 = lane & 31, hi = lane >> 5, row = 256 * rb + 32 * F.wave + r32;
    P1B_STAMP(F, 0);
    if (!PREFETCHED) { __syncthreads(); stage_w_dma<512>(F.WUQT + (size_t)192 * h * 256, F.lds, 192, F.wave, lane); }
    bf16x8 xf[16]; float ssq = 0.f;
    { const bf16* xr = F.CQ + (size_t)row * 256 + 8 * hi;
#pragma unroll
      for (int s = 0; s < 16; ++s) { const v4u xw = *(const GAS v4u*)(xr + 16 * s);
          const f32x4 x0 = {__uint_as_float(xw.x << 16), __uint_as_float(xw.x & 0xffff0000u), __uint_as_float(xw.y << 16), __uint_as_float(xw.y & 0xffff0000u)};
          const f32x4 x1 = {__uint_as_float(xw.z << 16), __uint_as_float(xw.z & 0xffff0000u), __uint_as_float(xw.w << 16), __uint_as_float(xw.w & 0xffff0000u)};
          const f32x4 g0 = *(const GAS f32x4*)(F.qan + 16 * s + 8 * hi), g1 = *(const GAS f32x4*)(F.qan + 16 * s + 8 * hi + 4);
          ssq += (x0.x * x0.x + x0.y * x0.y) + (x0.z * x0.z + x0.w * x0.w) + (x1.x * x1.x + x1.y * x1.y) + (x1.z * x1.z + x1.w * x1.w);
          const f32x4 y0 = x0 * g0, y1 = x1 * g1; v4u w; w.x = cvtpk(y0.x, y0.y); w.y = cvtpk(y0.z, y0.w); w.z = cvtpk(y1.x, y1.y); w.w = cvtpk(y1.z, y1.w); xf[s] = __builtin_bit_cast(bf16x8, w); } }
    const float rinv_a = rsqrtf(half_swap_add(ssq) * (1.f / 256.f) + RMS_EPS);
    P1B_STAMP(F, 1);
    __syncthreads();
    P1B_STAMP(F, 2);
    f32x16 acc[6]; rowown_mma_all<6, 16, 512>(acc, lds, xf, r32, hi);
    asm volatile("" : "+v"(acc[0]), "+v"(acc[5])); P1B_STAMP(F, 3);
    __syncthreads();
    stage_w_dma<256>(F.WUKT + (size_t)128 * h * 128, F.lds, 128, F.wave, lane);
    stage_w_dma<256>(F.WUVT + (size_t)128 * h * 128, F.lds + 32768, 128, F.wave, lane);
    float s2 = 0.f;
#pragma unroll
    for (int g = 0; g < 4; ++g) { const f32x4 c4 = *(const GAS f32x4*)(F.ROPE + (size_t)row * 64 + 8 * g + 4 * hi), s4 = *(const GAS f32x4*)(F.ROPE + (size_t)row * 64 + 32 + 8 * g + 4 * hi);
#pragma unroll
        for (int e = 0; e < 4; ++e) { const int r = 4 * g + e; const float cs = c4[e], sn = s4[e];
            const float x1 = acc[4][r] * rinv_a, x2 = acc[5][r] * rinv_a; acc[4][r] = x1 * cs - x2 * sn; acc[5][r] = x2 * cs + x1 * sn; } }
#pragma unroll
    for (int cb = 0; cb < 4; ++cb)
#pragma unroll
        for (int r = 0; r < 16; ++r) acc[cb][r] *= rinv_a;
#pragma unroll
    for (int cb = 0; cb < 6; ++cb)
#pragma unroll
        for (int r = 0; r < 16; ++r) s2 += acc[cb][r] * acc[cb][r];
    const float rinv2 = rsqrtf(half_swap_add(s2) * (1.f / 192.f) + RMS_EPS) * MLA_C;
#pragma unroll
    for (int cb = 0; cb < 6; ++cb)
#pragma unroll
        for (int g = 0; g < 4; ++g) { const f32x4 gn = *(const GAS f32x4*)(F.mqn + 32 * cb + 8 * g + 4 * hi);
            acc[cb][4 * g] *= rinv2 * gn.x; acc[cb][4 * g + 1] *= rinv2 * gn.y; acc[cb][4 * g + 2] *= rinv2 * gn.z; acc[cb][4 * g + 3] *= rinv2 * gn.w; }
    { char* stg = lds + 98304 + F.wave * 4096; bf16* q0 = F.QM + ((size_t)h * S + 256 * rb + 32 * F.wave) * 192;
      P1B_STAMP(F, 4); store_chunk64(acc[0], acc[1], stg, q0, 192, r32, hi, lane); store_chunk64(acc[2], acc[3], stg, q0 + 64, 192, r32, hi, lane); store_chunk64(acc[4], acc[5], stg, q0 + 128, 192, r32, hi, lane); }
    P1B_STAMP(F, 5);
}
__device__ __forceinline__ void p1b_kv_unit(Frame& F, int rb, int h, char* lds) {
    int lane_o = (int)__builtin_amdgcn_mbcnt_hi(~0u, __builtin_amdgcn_mbcnt_lo(~0u, 0u)); asm volatile("" : "+v"(lane_o));
    const int lane = lane_o, r32 = lane & 31, hi = lane >> 5, row = 256 * rb + 32 * F.wave + r32;
    bf16x8 xf[8]; float ssq = 0.f;
    { const bf16* xr = F.CKV + (size_t)row * 128 + 8 * hi;
#pragma unroll
      for (int s = 0; s < 8; ++s) { const v4u xw = *(const GAS v4u*)(xr + 16 * s);
          const f32x4 x0 = {__uint_as_float(xw.x << 16), __uint_as_float(xw.x & 0xffff0000u), __uint_as_float(xw.y << 16), __uint_as_float(xw.y & 0xffff0000u)};
          const f32x4 x1 = {__uint_as_float(xw.z << 16), __uint_as_float(xw.z & 0xffff0000u), __uint_as_float(xw.w << 16), __uint_as_float(xw.w & 0xffff0000u)};
          const f32x4 g0 = *(const GAS f32x4*)(F.kvan + 16 * s + 8 * hi), g1 = *(const GAS f32x4*)(F.kvan + 16 * s + 8 * hi + 4);
          ssq += (x0.x * x0.x + x0.y * x0.y) + (x0.z * x0.z + x0.w * x0.w) + (x1.x * x1.x + x1.y * x1.y) + (x1.z * x1.z + x1.w * x1.w);
          const f32x4 y0 = x0 * g0, y1 = x1 * g1; v4u w; w.x = cvtpk(y0.x, y0.y); w.y = cvtpk(y0.z, y0.w); w.z = cvtpk(y1.x, y1.y); w.w = cvtpk(y1.z, y1.w); xf[s] = __builtin_bit_cast(bf16x8, w); } }
    const float rinv_a = rsqrtf(half_swap_add(ssq) * (1.f / 128.f) + RMS_EPS);
    P1B_STAMP(F, 6);
    __syncthreads();
    P1B_STAMP(F, 7);
    { f32x16 av[4]; rowown_mma_all<4, 8, 256>(av, lds + 32768, xf, r32, hi);
#pragma unroll
      for (int cb = 0; cb < 4; ++cb)
#pragma unroll
          for (int r = 0; r < 16; ++r) av[cb][r] *= rinv_a;
      char* stg = lds + 98304 + F.wave * 4096; bf16* v0 = F.VM + ((size_t)h * S + 256 * rb + 32 * F.wave) * 128;
      store_chunk64(av[0], av[1], stg, v0, 128, r32, hi, lane); store_chunk64(av[2], av[3], stg, v0 + 64, 128, r32, hi, lane); }
    P1B_STAMP(F, 8);
    f32x16 ak[4]; rowown_mma_all<4, 8, 256>(ak, lds, xf, r32, hi);
    float pe1[16], pe2[16]; float s2 = 0.f;
    { const bf16* kr = F.KR + (size_t)row * 64 + 4 * hi;
#pragma unroll
      for (int g = 0; g < 4; ++g) { const u32x2 a = *(const GAS u32x2*)(kr + 8 * g), b = *(const GAS u32x2*)(kr + 32 + 8 * g);
          pe1[4 * g] = __uint_as_float(a.x << 16); pe1[4 * g + 1] = __uint_as_float(a.x & 0xffff0000u); pe1[4 * g + 2] = __uint_as_float(a.y << 16); pe1[4 * g + 3] = __uint_as_float(a.y & 0xffff0000u);
          pe2[4 * g] = __uint_as_float(b.x << 16); pe2[4 * g + 1] = __uint_as_float(b.x & 0xffff0000u); pe2[4 * g + 2] = __uint_as_float(b.y << 16); pe2[4 * g + 3] = __uint_as_float(b.y & 0xffff0000u); } }
#pragma unroll
    for (int g = 0; g < 4; ++g) { const f32x4 c4 = *(const GAS f32x4*)(F.ROPE + (size_t)row * 64 + 8 * g + 4 * hi), s4 = *(const GAS f32x4*)(F.ROPE + (size_t)row * 64 + 32 + 8 * g + 4 * hi);
#pragma unroll
        for (int e = 0; e < 4; ++e) { const int r = 4 * g + e; const float cs = c4[e], sn = s4[e]; const float x1 = pe1[r], x2 = pe2[r]; pe1[r] = x1 * cs - x2 * sn; pe2[r] = x2 * cs + x1 * sn; s2 += pe1[r] * pe1[r] + pe2[r] * pe2[r]; } }
#pragma unroll
    for (int cb = 0; cb < 4; ++cb)
#pragma unroll
        for (int r = 0; r < 16; ++r) { ak[cb][r] *= rinv_a; s2 += ak[cb][r] * ak[cb][r]; }
    const float rinv2 = rsqrtf(half_swap_add(s2) * (1.f / 192.f) + RMS_EPS);
#pragma unroll
    for (int cb = 0; cb < 4; ++cb)
#pragma unroll
        for (int g = 0; g < 4; ++g) { const f32x4 gn = *(const GAS f32x4*)(F.mkn + 32 * cb + 8 * g + 4 * hi);
            ak[cb][4 * g] *= rinv2 * gn.x; ak[cb][4 * g + 1] *= rinv2 * gn.y; ak[cb][4 * g + 2] *= rinv2 * gn.z; ak[cb][4 * g + 3] *= rinv2 * gn.w; }
    f32x16 p1v, p2v;
#pragma unroll
    for (int g = 0; g < 4; ++g) { const f32x4 g1 = *(const GAS f32x4*)(F.mkn + 128 + 8 * g + 4 * hi), g2 = *(const GAS f32x4*)(F.mkn + 160 + 8 * g + 4 * hi);
        p1v[4 * g] = pe1[4 * g] * rinv2 * g1.x; p1v[4 * g + 1] = pe1[4 * g + 1] * rinv2 * g1.y; p1v[4 * g + 2] = pe1[4 * g + 2] * rinv2 * g1.z; p1v[4 * g + 3] = pe1[4 * g + 3] * rinv2 * g1.w;
        p2v[4 * g] = pe2[4 * g] * rinv2 * g2.x; p2v[4 * g + 1] = pe2[4 * g + 1] * rinv2 * g2.y; p2v[4 * g + 2] = pe2[4 * g + 2] * rinv2 * g2.z; p2v[4 * g + 3] = pe2[4 * g + 3] * rinv2 * g2.w; }
    { char* stg = lds + 98304 + F.wave * 4096; bf16* k0 = F.KM + ((size_t)h * S + 256 * rb + 32 * F.wave) * 192;
      store_chunk64(ak[0], ak[1], stg, k0, 192, r32, hi, lane); store_chunk64(ak[2], ak[3], stg, k0 + 64, 192, r32, hi, lane); store_chunk64(p1v, p2v, stg, k0 + 128, 192, r32, hi, lane); }
    P1B_STAMP(F, 9);
}
__device__ __forceinline__ int p1b_unit_of(int b) { const int x = b & 7, j = b >> 3; return ((8 * x + (j >> 2)) << 2) | (j & 3); }
__device__ __forceinline__ void p1b_prefetch(Frame& F) {
    const int u = (blockIdx.x < 256 && F.G == 256) ? p1b_unit_of(blockIdx.x) : (int)blockIdx.x; if (blockIdx.x < 256) stage_w_dma<512>(F.WUQT + (size_t)192 * (u & 3) * 256, F.lds, 192, F.wave, (int)__builtin_amdgcn_mbcnt_hi(~0u, __builtin_amdgcn_mbcnt_lo(~0u, 0u)));
}
__device__ __forceinline__ void p1b_phase(Frame& F) {
    char* lds = (char*)F.lds;
    bool first = true;
#ifndef P1B_ABL
#define P1B_ABL 0
#endif
    for (int u0 = blockIdx.x; u0 < 256; u0 += F.G) { const int u = (F.G == 256) ? p1b_unit_of(u0) : u0; if (!(P1B_ABL & 1)) { if (first) p1b_q_unit<true>(F, u >> 2, u & 3, lds); else p1b_q_unit<false>(F, u >> 2, u & 3, lds); } first = false; if (!(P1B_ABL & 2)) p1b_kv_unit(F, u >> 2, u & 3, lds); }
    __syncthreads();
}
}
namespace mk {
constexpr int AL_V = 0, AL_K = 49152, AL_WS = 49152 + 73728, AL_TBL = AL_WS + 2048, AL_BC = AL_TBL + 1024, AL_X = 0, AL_STG = 65536, AL_TICKET = 131072;
#define SBAR() __builtin_amdgcn_sched_barrier(0)
#ifndef QK_SB
#define QK_SB 4
#endif
__device__ __forceinline__ int v_st(int k, int c) { return ((k >> 3) * 4 + (c >> 5)) * 512 + ((k & 7) * 32 + (c & 31)) * 2; }
__device__ __forceinline__ int v_rd_base(int lane) { return ((lane & 3) << 3) | (((lane >> 2) & 3) << 6) | (((lane >> 4) & 1) << 5) | (((lane >> 5) & 1) << 8); }
constexpr int v_rd_off(int d0, int ks, int half) { return d0 * 512 + ks * 4096 + half * 2048; }
typedef short v4i16_t __attribute__((ext_vector_type(4)));
template <int OFF> __device__ __forceinline__ s16x4 tr_read(int vb) {
    return __builtin_bit_cast(s16x4, __builtin_amdgcn_ds_read_tr16_b64_v4i16((LAS v4i16_t*)(unsigned)(vb + OFF))); }
template <int D0> __device__ __forceinline__ void pv_one(f32x16& od, int vb, bf16x8 pa0, bf16x8 pa1, bf16x8 pa2, bf16x8 pa3) {
    const s16x4 l0 = tr_read<v_rd_off(D0, 0, 0)>(vb), h0 = tr_read<v_rd_off(D0, 0, 1)>(vb), l1 = tr_read<v_rd_off(D0, 1, 0)>(vb), h1 = tr_read<v_rd_off(D0, 1, 1)>(vb);
    const s16x4 l2 = tr_read<v_rd_off(D0, 2, 0)>(vb), h2 = tr_read<v_rd_off(D0, 2, 1)>(vb), l3 = tr_read<v_rd_off(D0, 3, 0)>(vb), h3 = tr_read<v_rd_off(D0, 3, 1)>(vb);
    asm volatile("s_waitcnt lgkmcnt(0)" ::: "memory"); SBAR();
#define PK(L, H) (bf16x8){L[0], L[1], L[2], L[3], H[0], H[1], H[2], H[3]}
    od = __builtin_amdgcn_mfma_f32_32x32x16_bf16(pa0, PK(l0, h0), od, 0, 0, 0);
    od = __builtin_amdgcn_mfma_f32_32x32x16_bf16(pa1, PK(l1, h1), od, 0, 0, 0);
    od = __builtin_amdgcn_mfma_f32_32x32x16_bf16(pa2, PK(l2, h2), od, 0, 0, 0);
    od = __builtin_amdgcn_mfma_f32_32x32x16_bf16(pa3, PK(l3, h3), od, 0, 0, 0);
#undef PK
}
__device__ __forceinline__ void pv_all(f32x16* o, int vb, bf16x8 pa0, bf16x8 pa1, bf16x8 pa2, bf16x8 pa3) {
    pv_one<0>(o[0], vb, pa0, pa1, pa2, pa3); pv_one<1>(o[1], vb, pa0, pa1, pa2, pa3); pv_one<2>(o[2], vb, pa0, pa1, pa2, pa3); pv_one<3>(o[3], vb, pa0, pa1, pa2, pa3);
}
__device__ __forceinline__ bf16x8 pack8(const f32x16& p, int b) {
    v4u w; w.x = cvtpk(p[b], p[b + 1]); w.y = cvtpk(p[b + 2], p[b + 3]); w.z = cvtpk(p[b + 4], p[b + 5]); w.w = cvtpk(p[b + 6], p[b + 7]); return __builtin_bit_cast(bf16x8, w);
}
template <int HF> __device__ __forceinline__ void vread_all(int vb, s16x4 (&vl)[8], s16x4 (&vh)[8]) {
    vl[0] = tr_read<v_rd_off(0, 2 * HF, 0)>(vb); vh[0] = tr_read<v_rd_off(0, 2 * HF, 1)>(vb); vl[1] = tr_read<v_rd_off(0, 2 * HF + 1, 0)>(vb); vh[1] = tr_read<v_rd_off(0, 2 * HF + 1, 1)>(vb);
    vl[2] = tr_read<v_rd_off(1, 2 * HF, 0)>(vb); vh[2] = tr_read<v_rd_off(1, 2 * HF, 1)>(vb); vl[3] = tr_read<v_rd_off(1, 2 * HF + 1, 0)>(vb); vh[3] = tr_read<v_rd_off(1, 2 * HF + 1, 1)>(vb);
    vl[4] = tr_read<v_rd_off(2, 2 * HF, 0)>(vb); vh[4] = tr_read<v_rd_off(2, 2 * HF, 1)>(vb); vl[5] = tr_read<v_rd_off(2, 2 * HF + 1, 0)>(vb); vh[5] = tr_read<v_rd_off(2, 2 * HF + 1, 1)>(vb);
    vl[6] = tr_read<v_rd_off(3, 2 * HF, 0)>(vb); vh[6] = tr_read<v_rd_off(3, 2 * HF, 1)>(vb); vl[7] = tr_read<v_rd_off(3, 2 * HF + 1, 0)>(vb); vh[7] = tr_read<v_rd_off(3, 2 * HF + 1, 1)>(vb);
}
__device__ __forceinline__ void pv_mma(f32x16* o, bf16x8 pa0, bf16x8 pa1, const s16x4 (&vl)[8], const s16x4 (&vh)[8]) {
    asm volatile("s_waitcnt lgkmcnt(0)" ::: "memory"); SBAR();
#define PK(L, H) (bf16x8){L[0], L[1], L[2], L[3], H[0], H[1], H[2], H[3]}
    o[0] = __builtin_amdgcn_mfma_f32_32x32x16_bf16(pa0, PK(vl[0], vh[0]), o[0], 0, 0, 0);
    o[1] = __builtin_amdgcn_mfma_f32_32x32x16_bf16(pa0, PK(vl[2], vh[2]), o[1], 0, 0, 0);
    o[2] = __builtin_amdgcn_mfma_f32_32x32x16_bf16(pa0, PK(vl[4], vh[4]), o[2], 0, 0, 0);
    o[3] = __builtin_amdgcn_mfma_f32_32x32x16_bf16(pa0, PK(vl[6], vh[6]), o[3], 0, 0, 0);
    o[0] = __builtin_amdgcn_mfma_f32_32x32x16_bf16(pa1, PK(vl[1], vh[1]), o[0], 0, 0, 0);
    o[1] = __builtin_amdgcn_mfma_f32_32x32x16_bf16(pa1, PK(vl[3], vh[3]), o[1], 0, 0, 0);
    o[2] = __builtin_amdgcn_mfma_f32_32x32x16_bf16(pa1, PK(vl[5], vh[5]), o[2], 0, 0, 0);
    o[3] = __builtin_amdgcn_mfma_f32_32x32x16_bf16(pa1, PK(vl[7], vh[7]), o[3], 0, 0, 0);
#undef PK
}
template <int HF> __device__ __forceinline__ void vread_lo(int vb, s16x4 (&vl)[8], s16x4 (&vh)[8]) {
    vl[0] = tr_read<v_rd_off(0, 2 * HF, 0)>(vb); vh[0] = tr_read<v_rd_off(0, 2 * HF, 1)>(vb); vl[1] = tr_read<v_rd_off(0, 2 * HF + 1, 0)>(vb); vh[1] = tr_read<v_rd_off(0, 2 * HF + 1, 1)>(vb);
    vl[2] = tr_read<v_rd_off(1, 2 * HF, 0)>(vb); vh[2] = tr_read<v_rd_off(1, 2 * HF, 1)>(vb); vl[3] = tr_read<v_rd_off(1, 2 * HF + 1, 0)>(vb); vh[3] = tr_read<v_rd_off(1, 2 * HF + 1, 1)>(vb);
}
template <int HF> __device__ __forceinline__ void pv_mma_split(f32x16* o, int vb, bf16x8 pa0, bf16x8 pa1, s16x4 (&vl)[8], s16x4 (&vh)[8]) {
    asm volatile("s_waitcnt lgkmcnt(0)" ::: "memory"); SBAR();
    vl[4] = tr_read<v_rd_off(2, 2 * HF, 0)>(vb); vh[4] = tr_read<v_rd_off(2, 2 * HF, 1)>(vb); vl[5] = tr_read<v_rd_off(2, 2 * HF + 1, 0)>(vb); vh[5] = tr_read<v_rd_off(2, 2 * HF + 1, 1)>(vb);
    vl[6] = tr_read<v_rd_off(3, 2 * HF, 0)>(vb); vh[6] = tr_read<v_rd_off(3, 2 * HF, 1)>(vb); vl[7] = tr_read<v_rd_off(3, 2 * HF + 1, 0)>(vb); vh[7] = tr_read<v_rd_off(3, 2 * HF + 1, 1)>(vb);
#define PK(L, H) (bf16x8){L[0], L[1], L[2], L[3], H[0], H[1], H[2], H[3]}
    o[0] = __builtin_amdgcn_mfma_f32_32x32x16_bf16(pa0, PK(vl[0], vh[0]), o[0], 0, 0, 0);
    o[1] = __builtin_amdgcn_mfma_f32_32x32x16_bf16(pa0, PK(vl[2], vh[2]), o[1], 0, 0, 0);
    o[0] = __builtin_amdgcn_mfma_f32_32x32x16_bf16(pa1, PK(vl[1], vh[1]), o[0], 0, 0, 0);
    o[1] = __builtin_amdgcn_mfma_f32_32x32x16_bf16(pa1, PK(vl[3], vh[3]), o[1], 0, 0, 0);
    asm volatile("s_waitcnt lgkmcnt(0)" ::: "memory"); SBAR();
    o[2] = __builtin_amdgcn_mfma_f32_32x32x16_bf16(pa0, PK(vl[4], vh[4]), o[2], 0, 0, 0);
    o[3] = __builtin_amdgcn_mfma_f32_32x32x16_bf16(pa0, PK(vl[6], vh[6]), o[3], 0, 0, 0);
    o[2] = __builtin_amdgcn_mfma_f32_32x32x16_bf16(pa1, PK(vl[5], vh[5]), o[2], 0, 0, 0);
    o[3] = __builtin_amdgcn_mfma_f32_32x32x16_bf16(pa1, PK(vl[7], vh[7]), o[3], 0, 0, 0);
#undef PK
}
__device__ __forceinline__ unsigned cvtpk_s(float lo, float hi) { typedef float f2_t __attribute__((ext_vector_type(2))); typedef __bf16 b2_t __attribute__((ext_vector_type(2)));
    f2_t v = {lo, hi}; b2_t b = __builtin_convertvector(v, b2_t); return __builtin_bit_cast(unsigned, b); }
__device__ __forceinline__ void glds16(const void* gsrc, unsigned lds_dst) { unsigned keep;
    asm volatile("s_mov_b32 %0, m0\n\ts_mov_b32 m0, %2\n\ts_nop 0\n\tglobal_load_lds_dwordx4 %1, off\n\ts_mov_b32 m0, %0" : "=&s"(keep) : "v"(gsrc), "s"(lds_dst) : "memory"); }
__device__ __forceinline__ float fadd_s(float a, float b) { float r; asm("v_add_f32_e32 %0, %1, %2" : "=v"(r) : "v"(a), "v"(b)); return r; }
template <int B> __device__ __forceinline__ void mma16(f32x16& c, bf16x8 a, bf16x8 b) {
    f32x4 t = {c[B], c[B + 1], c[B + 2], c[B + 3]}; t = __builtin_amdgcn_mfma_f32_16x16x32_bf16(a, b, t, 0, 0, 0); c[B] = t[0]; c[B + 1] = t[1]; c[B + 2] = t[2]; c[B + 3] = t[3]; }
template <int B> __device__ __forceinline__ void mma16z(f32x16& c, bf16x8 a, bf16x8 b) {
    f32x4 t = {0.f, 0.f, 0.f, 0.f}; t = __builtin_amdgcn_mfma_f32_16x16x32_bf16(a, b, t, 0, 0, 0); c[B] = t[0]; c[B + 1] = t[1]; c[B + 2] = t[2]; c[B + 3] = t[3]; }
constexpr int v_off16(int dt, int hf, int blk) { return hf * 8192 + blk * 4096 + (dt >> 1) * 512; }
template <bool DIFF>
__device__ __forceinline__ void attn_unit(Frame& F, int h, int qb, char* lds) {
    constexpr int KS2 = DIFF ? 2 : 6, KROWB = DIFF ? 256 : 384, KTILE = 64 * KROWB, NKC = KTILE / (512 * 16), KBUF = 24576, VBUF = 16384, QLD = DIFF ? 128 : 192;
    int tid_o = F.wave * 64 + (int)__builtin_amdgcn_mbcnt_hi(~0u, __builtin_amdgcn_mbcnt_lo(~0u, 0u)); asm volatile("" : "+v"(tid_o));
    const int tid = tid_o, wid = F.wave, lane = tid & 63, l16 = lane & 15, g = lane >> 4;
    const int cmap = DIFF ? (wid >> 2) : 0, rg = DIFF ? (wid & 3) : wid;
    const int R0 = (DIFF ? 128 : 256) * qb;
    const int chunk_w = __builtin_amdgcn_readfirstlane((DIFF ? 2 * qb : 4 * qb) + (rg >> 1)), NT = (DIFF ? 2 * qb : 4 * qb) + (DIFF ? 2 : 4);
    char* V_lds = lds + AL_V; char* K_lds = lds + AL_K; float* tbl = (float*)(lds + AL_TBL);
    const bf16* Kg = (DIFF ? F.DK + (size_t)h * S * 128 : F.KM + (size_t)h * S * 192);
    const bf16* Vg = (DIFF ? F.DV : F.VM) + (size_t)h * S * 128;
    if (DIFF) { if (tid < 255) { const int rel = tid - 191; tbl[tid] = (F.rel_bias[t5_bucket(rel) * 4 + h] - F.rel_bias[15 * 4 + h]) * LOG2E; } }
    bf16x8 qr[2][KS2];
    { const bf16* Qw = (DIFF ? F.DQ + ((size_t)h * S + R0 + 32 * rg + l16) * 128 + 64 * cmap : F.QM + ((size_t)h * S + R0 + 32 * rg + l16) * 192) + 8 * g;
#pragma unroll
      for (int rt = 0; rt < 2; ++rt)
#pragma unroll
          for (int k2 = 0; k2 < KS2; ++k2) qr[rt][k2] = *(const GAS bf16x8*)(Qw + (size_t)16 * rt * QLD + 32 * k2); }
    const int vlane = (g >> 1) * 2048 + (g & 1) * 256 + (l16 >> 2) * 64 + ((l16 >> 1) & 1) * 16 + (l16 & 1) * 8;
    const int vbE0 = (int)(uintptr_t)V_lds + vlane + 32 * (g & 1), vbO0 = (int)(uintptr_t)V_lds + vlane + 32 * (1 - (g & 1));
    const int kro = l16 * KROWB, kx = DIFF ? (l16 << 4) : (((l16 >> 1) & 7) << 4), kc0 = DIFF ? (128 * cmap + 16 * g) : (16 * g);
    const int tb0 = 191 + 4 * g - (32 * (rg & 1) + l16) - 64 * chunk_w;
    auto ksrc = [&](int i) -> unsigned { const int p = (wid * NKC + i) * 64 + lane; if (DIFF) { const int row = p >> 4, ch = (p & 15) ^ (row & 15); return (unsigned)(row * 256 + ch * 16); } else { const int row = p / 24, ch = (p % 24) ^ ((row >> 1) & 7); return (unsigned)(row * 384 + ch * 16); } };
    auto vsrc = [&](int i) -> unsigned { const int p = (wid * 2 + i) * 64 + lane, sub = p >> 5, r = (p & 31) >> 2, key = (sub >> 2) * 8 + r, col = (sub & 3) * 32 + ((p & 3) ^ ((r >> 2) << 1)) * 8; return (unsigned)(key * 256 + col * 2); };
    const unsigned lds_k0 = (unsigned)(uintptr_t)K_lds + (unsigned)(wid * NKC) * 1024u, lds_v0 = (unsigned)(uintptr_t)V_lds + (unsigned)(wid * 2) * 1024u;
#ifndef ABL
#define ABL 0
#endif
#define DMA(t, sl) do { if (ABL & 1) break; const char* kt_ = (const char*)Kg + (size_t)(t) * KTILE; const char* vt_ = (const char*)Vg + (size_t)(t) * 16384; \
        _Pragma("unroll") for (int i_ = 0; i_ < NKC; ++i_) glds16(kt_ + ksrc(i_), (unsigned)__builtin_amdgcn_readfirstlane(lds_k0 + (unsigned)(sl) * KBUF + i_ * 1024)); \
        _Pragma("unroll") for (int i_ = 0; i_ < 2; ++i_) glds16(vt_ + vsrc(i_), (unsigned)__builtin_amdgcn_readfirstlane(lds_v0 + (unsigned)(sl) * VBUF + i_ * 1024)); } while (0)
#define DMA1(t, sl, pc) do { if (ABL & 1) break; if ((pc) < NKC) glds16((const char*)Kg + (size_t)(t) * KTILE + ksrc(pc), (unsigned)__builtin_amdgcn_readfirstlane(lds_k0 + (unsigned)(sl) * KBUF + (pc) * 1024)); \
        else glds16((const char*)Vg + (size_t)(t) * 16384 + vsrc((pc) - NKC), (unsigned)__builtin_amdgcn_readfirstlane(lds_v0 + (unsigned)(sl) * VBUF + ((pc) - NKC) * 1024)); } while (0)
#define KFRAG(kb, kt, k2) (*(const bf16x8*)((kb) + (kt) * 16 * KROWB + ((kc0 + 64 * (k2)) ^ kx)))
#define KPREF(kb) do { kf[0] = KFRAG(kb, 0, 0); kf[1] = KFRAG(kb, 1, 0); kf[2] = KFRAG(kb, 0, 1); kf[3] = KFRAG(kb, 1, 1); } while (0)
#define POSTQK_H(P, t, HF) do { if ((t) > chunk_w) { _Pragma("unroll") for (int r = 0; r < 16; ++r) P[r] = -1e30f; } \
        else if (DIFF && (t) + 2 >= chunk_w) { const float* tb_ = tbl + (tb0 + 64 * (t) + 32 * (HF)); \
            _Pragma("unroll") for (int r = 0; r < 16; ++r) P[r] += tb_[16 * ((r >> 2) & 1) + (r & 3) - 16 * (r >> 3)]; } } while (0)
#define VR1(i, dt, HF, vE, vO) do { vl[i] = tr_read<v_off16(dt, HF, 0)>(((dt) & 1) ? (vO) : (vE)); vh[i] = tr_read<v_off16(dt, HF, 1)>(((dt) & 1) ? (vO) : (vE)); } while (0)
#define VRDG(HF, vE, vO, q) do { if (DIFF) { VR1(2 * (q), 2 * (q), HF, vE, vO); VR1(2 * (q) + 1, 2 * (q) + 1, HF, vE, vO); } else { VR1(q, q, HF, vE, vO); } } while (0)
#define VRD(HF, vE, vO) do { VRDG(HF, vE, vO, 0); VRDG(HF, vE, vO, 1); VRDG(HF, vE, vO, 2); VRDG(HF, vE, vO, 3); } while (0)
#define SUMPK4(Pp, e) do { pw[(e) / 2] = cvtpk_s(Pp[e], Pp[(e) + 1]); pw[(e) / 2 + 1] = cvtpk_s(Pp[(e) + 2], Pp[(e) + 3]); asm volatile("" : "+v"(pw[(e) / 2]), "+v"(pw[(e) / 2 + 1])); } while (0)
#define SUMPK2(Pp, e) do { pw[(e) / 2] = cvtpk_s(Pp[e], Pp[(e) + 1]); asm volatile("" : "+v"(pw[(e) / 2])); } while (0)
#define PHASE_A(Pc, Pp, kb, HAVE_PREV, VHF, vE, vO, DODMA) do { \
        _Pragma("unroll") for (int i_ = 0; i_ < KS2; ++i_) { \
            if (i_ == 0) { mma16z<0>(Pc, kf[0], qr[0][0]); mma16z<4>(Pc, kf[1], qr[0][0]); } else { mma16<0>(Pc, kf[2 * (i_ & 1)], qr[0][i_]); mma16<4>(Pc, kf[2 * (i_ & 1) + 1], qr[0][i_]); } \
            if (!DIFF && (DODMA) && i_ < NKC + 2) DMA1(t + 2, sk_w, i_); \
            if (HAVE_PREV) { if (DIFF) SUMPK4(Pp, 8 * i_); else if (i_ < 4) SUMPK2(Pp, 4 * i_); \
                if (i_ == 0) VRDG(VHF, vE, vO, 0); if (i_ == 1) VRDG(VHF, vE, vO, 2); } \
            SBAR(); \
            if (i_ == 0) { mma16z<8>(Pc, kf[0], qr[1][0]); mma16z<12>(Pc, kf[1], qr[1][0]); } else { mma16<8>(Pc, kf[2 * (i_ & 1)], qr[1][i_]); mma16<12>(Pc, kf[2 * (i_ & 1) + 1], qr[1][i_]); } \
            if (i_ + 2 < KS2) { kf[2 * (i_ & 1)] = KFRAG(kb, 0, i_ + 2); kf[2 * (i_ & 1) + 1] = KFRAG(kb, 1, i_ + 2); } \
            if (HAVE_PREV) { if (DIFF) SUMPK4(Pp, 8 * i_ + 4); else if (i_ < 4) SUMPK2(Pp, 4 * i_ + 2); \
                if (i_ == 0) VRDG(VHF, vE, vO, 1); if (i_ == 1) VRDG(VHF, vE, vO, 3); } \
            SBAR(); } } while (0)
#define PAV(k) __builtin_bit_cast(bf16x8, (v4u){pw[4 * (k)], pw[4 * (k) + 1], pw[4 * (k) + 2], pw[4 * (k) + 3]})
#define VFR(i) (bf16x8){vl[i][0], vl[i][1], vl[i][2], vl[i][3], vh[i][0], vh[i][1], vh[i][2], vh[i][3]}
#define PVP(dt, VI, Pc, DOEXP) do { mma16<8 * ((dt) & 1)>(o[(dt) >> 1], VFR(VI), PAV(0)); mma16<8 * ((dt) & 1) + 4>(o[(dt) >> 1], VFR(VI), PAV(1)); \
        if (DOEXP) { Pc[2 * (dt)] = __builtin_amdgcn_exp2f(Pc[2 * (dt)]); Pc[2 * (dt) + 1] = __builtin_amdgcn_exp2f(Pc[2 * (dt) + 1]); asm volatile("" : "+v"(Pc[2 * (dt)]), "+v"(Pc[2 * (dt) + 1])); } SBAR(); } while (0)
#define PHASE_B(Pc, HF, vE, vO, DOEXP, kbnext, DOPREF, BDMA) do { \
        if (DIFF) { PVP(0, 0, Pc, DOEXP); if ((BDMA) && dma_) DMA1(t + 2, sk_w, 0); PVP(1, 1, Pc, DOEXP); PVP(2, 2, Pc, DOEXP); if ((BDMA) && dma_) DMA1(t + 2, sk_w, 1); PVP(3, 3, Pc, DOEXP); \
            if (DOPREF) kf[0] = KFRAG(kbnext, 0, 0); PVP(4, 4, Pc, DOEXP); if ((BDMA) && dma_) DMA1(t + 2, sk_w, 2); if (DOPREF) kf[1] = KFRAG(kbnext, 1, 0); PVP(5, 5, Pc, DOEXP); if (DOPREF) kf[2] = KFRAG(kbnext, 0, 1); PVP(6, 6, Pc, DOEXP); if ((BDMA) && dma_) DMA1(t + 2, sk_w, 3); if (DOPREF) kf[3] = KFRAG(kbnext, 1, 1); PVP(7, 7, Pc, DOEXP); } \
        else { PVP(0, 0, Pc, DOEXP); PVP(1, 1, Pc, DOEXP); VR1(0, 4, HF, vE, vO); VR1(1, 5, HF, vE, vO); SBAR(); \
            PVP(2, 2, Pc, DOEXP); PVP(3, 3, Pc, DOEXP); VR1(2, 6, HF, vE, vO); VR1(3, 7, HF, vE, vO); SBAR(); \
            if (DOPREF) { KPREF(kbnext); SBAR(); } \
            PVP(4, 0, Pc, DOEXP); PVP(5, 1, Pc, DOEXP); PVP(6, 2, Pc, DOEXP); PVP(7, 3, Pc, DOEXP); } \
        ls0 = __builtin_amdgcn_mfma_f32_16x16x32_bf16(ones, PAV(0), ls0, 0, 0, 0); ls1 = __builtin_amdgcn_mfma_f32_16x16x32_bf16(ones, PAV(1), ls1, 0, 0, 0); SBAR(); } while (0)
    const bf16x8 ones = {16256, 16256, 16256, 16256, 16256, 16256, 16256, 16256}; f32x4 ls0 = {0.f, 0.f, 0.f, 0.f}, ls1 = {0.f, 0.f, 0.f, 0.f};
    f32x16 o[4] = {}; f32x16 Pa, Pb; unsigned pw[8]; s16x4 vl[8], vh[8]; bf16x8 kf[4];
    __syncthreads();
    DMA(0, 0); DMA(1, 1); if (2 < NT) DMA(2, 2);
    asm volatile("s_waitcnt vmcnt(0)" ::: "memory"); __syncthreads();
    { const char* kb_ = K_lds + kro; KPREF(kb_); { const int t = 0, sk_w = 0; PHASE_A(Pa, Pa, kb_, false, 0, vbE0, vbO0, false); } POSTQK_H(Pa, 0, 0);
#pragma unroll
      for (int r = 0; r < 16; ++r) Pa[r] = __builtin_amdgcn_exp2f(Pa[r]);
      KPREF(kb_ + 32 * KROWB); }
    int sk_c = 0, sk_n = 1, sk_w = 2;
#define ITER(SPECIAL) do { \
        const bool dma_ = (t >= 1 && t + 2 < NT); \
        const char* kb1 = K_lds + sk_c * KBUF + 32 * KROWB + kro; const char* kbn = K_lds + sk_n * KBUF + kro; const int vE = vbE0 + sk_c * VBUF, vO = vbO0 + sk_c * VBUF; \
        PHASE_A(Pb, Pa, kb1, true, 0, vE, vO, dma_); if (SPECIAL) POSTQK_H(Pb, t, 1); \
        if (t + 1 < NT) { \
            PHASE_B(Pb, 0, vE, vO, true, kbn, true, true); \
            PHASE_A(Pa, Pb, kbn, true, 1, vE, vO, false); if (SPECIAL) POSTQK_H(Pa, t + 1, 0); PHASE_B(Pa, 1, vE, vO, true, kbn + 32 * KROWB, true, false); \
        } else { \
            PHASE_B(Pb, 0, vE, vO, true, kbn, false, false); \
            VRD(1, vE, vO); \
            { _Pragma("unroll") for (int i_ = 0; i_ < 4; ++i_) { pw[i_] = cvtpk_s(Pb[2 * i_], Pb[2 * i_ + 1]); pw[4 + i_] = cvtpk_s(Pb[8 + 2 * i_], Pb[8 + 2 * i_ + 1]); } } \
            PHASE_B(Pb, 1, vE, vO, false, kbn, false, false); \
        } \
        asm volatile("s_waitcnt vmcnt(0)" ::: "memory"); __syncthreads(); \
        { const int tmp = sk_c; sk_c = sk_n; sk_n = sk_w; sk_w = tmp; } } while (0)
    int t = 0;
    for (; t + 5 < NT; ++t) ITER(false);
    unsigned tk = 0u; int nenc = -1;
    for (; t < NT; ++t) {
        if (wid == 0) { if (t == NT - 2) { if (lane == 0) tk = __hip_atomic_fetch_add(F.ctl + CW_QUEUE, 1u, __ATOMIC_RELAXED, __HIP_MEMORY_SCOPE_AGENT); }
                        else if (t == NT - 1) { if (lane == 0) nenc = tk < 768u ? (int)((const GAS unsigned short*)(F.MODF + 4096))[tk] : -1; } }
        ITER(true); }
    if (wid == 0 && lane == 0) *(volatile int*)(lds + AL_TICKET) = nenc;
#undef ITER
#undef KFRAG
#undef KPREF
#undef PHASE_A
#undef PHASE_B
#undef PAV
#undef VFR
#undef PVP
#undef VR1
#undef VRDG
#undef SUMPK4
#undef SUMPK2
    int lane2 = lane; asm volatile("" : "+v"(lane2));
    const int ch = lane2 & 15; const bool writer = !DIFF || cmap == 0; const int colbase = DIFF ? h * 128 : 512 + h * 128;
    v4u sgv[8]; f32x4 gs0 = {1.f, 1.f, 1.f, 1.f}, gs1 = {1.f, 1.f, 1.f, 1.f}; float lam = 0.f;
    if (writer) {
#pragma unroll
        for (int i = 0; i < 8; ++i) sgv[i] = *(const GAS v4u*)(F.SG + (size_t)(R0 + 32 * rg + 4 * i + (lane2 >> 4)) * DM + colbase + 8 * ch);
        if (DIFF) { gs0 = *(const GAS f32x4*)(F.dsub + 8 * ch); gs1 = *(const GAS f32x4*)(F.dsub + 8 * ch + 4); }
    } else lam = F.MODF[3072];
    const float rl0 = __builtin_amdgcn_rcpf(ls0[0]), rl1 = __builtin_amdgcn_rcpf(ls1[0]);
    __syncthreads();
    char* stg = lds + AL_STG + wid * 8192;
    const int l16b = lane2 & 15, gb = lane2 >> 4;
#define STG_PUT(D, q, v0, v1, v2, v3) do { const int dt_ = 2 * (D) + ((q) >> 1), rt_ = (q) & 1; u32x2 w_; w_.x = cvtpk(v0, v1); w_.y = cvtpk(v2, v3); \
        *(u32x2*)(stg + (16 * rt_ + l16b) * 256 + (((2 * dt_ + (gb >> 1)) ^ l16b) << 4) + 8 * (gb & 1)) = w_; } while (0)
    if (DIFF) {
        f32x4* X4 = (f32x4*)(lds + AL_X) + rg * 1024 + lane;
        if (cmap == 1) {
#pragma unroll
            for (int D = 0; D < 4; ++D)
#pragma unroll
                for (int q = 0; q < 4; ++q) { const float rl = lam * ((q & 1) ? rl1 : rl0); X4[(D * 4 + q) * 64] = (f32x4){o[D][4 * q] * rl, o[D][4 * q + 1] * rl, o[D][4 * q + 2] * rl, o[D][4 * q + 3] * rl}; }
        }
        __syncthreads();
        if (cmap == 0) {
            f32x4 xq[16];
#pragma unroll
            for (int k = 0; k < 16; ++k) xq[k] = *(const LAS f32x4*)(unsigned)(uintptr_t)(X4 + k * 64);
            asm volatile("s_waitcnt lgkmcnt(0)" ::: "memory");
#pragma unroll
            for (int D = 0; D < 4; ++D)
#pragma unroll
                for (int q = 0; q < 4; ++q) { const f32x4 x = xq[D * 4 + q]; const float rl = (q & 1) ? rl1 : rl0;
                    STG_PUT(D, q, o[D][4 * q] * rl - x[0], o[D][4 * q + 1] * rl - x[1], o[D][4 * q + 2] * rl - x[2], o[D][4 * q + 3] * rl - x[3]); }
        }
    } else {
#pragma unroll
        for (int D = 0; D < 4; ++D)
#pragma unroll
            for (int q = 0; q < 4; ++q) { const float rl = (q & 1) ? rl1 : rl0; STG_PUT(D, q, o[D][4 * q] * rl, o[D][4 * q + 1] * rl, o[D][4 * q + 2] * rl, o[D][4 * q + 3] * rl); }
    }
#undef STG_PUT
    if (writer) {
        asm volatile("s_waitcnt lgkmcnt(0)" ::: "memory");
        v4u vst[8];
#pragma unroll
        for (int i = 0; i < 8; ++i) { const int row = 4 * i + (lane2 >> 4); vst[i] = *(const LAS v4u*)(unsigned)(uintptr_t)(stg + row * 256 + ((ch ^ (row & 15)) << 4)); }
        asm volatile("s_waitcnt lgkmcnt(0)" ::: "memory");
#pragma unroll
        for (int i = 0; i < 8; ++i) { const int row = 4 * i + (lane2 >> 4); const size_t off = (size_t)(R0 + 32 * rg + row) * DM + colbase + 8 * ch;
            const v4u v = vst[i]; const v4u g = sgv[i];
            float f[8] = {__uint_as_float(v.x << 16), __uint_as_float(v.x & 0xffff0000u), __uint_as_float(v.y << 16), __uint_as_float(v.y & 0xffff0000u),
                          __uint_as_float(v.z << 16), __uint_as_float(v.z & 0xffff0000u), __uint_as_float(v.w << 16), __uint_as_float(v.w & 0xffff0000u)};
            if (DIFF) {
                float ss = (f[0] * f[0] + f[1] * f[1]) + (f[2] * f[2] + f[3] * f[3]) + (f[4] * f[4] + f[5] * f[5]) + (f[6] * f[6] + f[7] * f[7]);
                ss += __int_as_float(__builtin_amdgcn_update_dpp(0, __float_as_int(ss), 0xB1, 0xF, 0xF, true));
                ss += __int_as_float(__builtin_amdgcn_update_dpp(0, __float_as_int(ss), 0x4E, 0xF, 0xF, true));
                ss += __int_as_float(__builtin_amdgcn_update_dpp(0, __float_as_int(ss), 0x141, 0xF, 0xF, true));
                ss += __int_as_float(__builtin_amdgcn_update_dpp(0, __float_as_int(ss), 0x140, 0xF, 0xF, true));
                const float rs = rsqrtf(ss * (1.f / 128.f) + RMS_EPS) * 0.8f;
                f[0] *= rs * gs0.x; f[1] *= rs * gs0.y; f[2] *= rs * gs0.z; f[3] *= rs * gs0.w; f[4] *= rs * gs1.x; f[5] *= rs * gs1.y; f[6] *= rs * gs1.z; f[7] *= rs * gs1.w; }
            v4u w;
            w.x = cvtpk(f[0] * __uint_as_float(g.x << 16), f[1] * __uint_as_float(g.x & 0xffff0000u));
            w.y = cvtpk(f[2] * __uint_as_float(g.y << 16), f[3] * __uint_as_float(g.y & 0xffff0000u));
            w.z = cvtpk(f[4] * __uint_as_float(g.z << 16), f[5] * __uint_as_float(g.z & 0xffff0000u));
            w.w = cvtpk(f[6] * __uint_as_float(g.w << 16), f[7] * __uint_as_float(g.w & 0xffff0000u));
            *(GAS v4u*)(F.A3 + off) = w; }
    }
#ifdef FUSE_P3
    asm volatile("s_waitcnt vmcnt(0)" ::: "memory"); __syncthreads();
    if (wid == 0 && lane2 == 0) { __builtin_amdgcn_fence(__ATOMIC_RELEASE, "agent"); asm volatile("s_waitcnt vmcnt(0)" ::: "memory");
        __hip_atomic_fetch_add(F.ctl + CW_DONE + 16 * (DIFF ? (qb >> 1) : qb), 1u, __ATOMIC_RELAXED, __HIP_MEMORY_SCOPE_AGENT); }
#endif
#undef DMA
#undef DMA1
#undef VRD
#undef POSTQK_H
}
#ifndef ATT_ONLY
#define ATT_ONLY 3
#endif
__device__ __forceinline__ void attn_phase(Frame& F) {
    char* lds = (char*)F.lds; volatile int* bc = (volatile int*)(lds + AL_TICKET) - 1;
    const unsigned short* ord = (const unsigned short*)(F.MODF + 4096);
    __syncthreads();
    if (F.wave == 0 && __builtin_amdgcn_mbcnt_hi(~0u, __builtin_amdgcn_mbcnt_lo(~0u, 0u)) == 0u) {
        const unsigned idx = __hip_atomic_fetch_add(F.ctl + CW_QUEUE, 1u, __ATOMIC_RELAXED, __HIP_MEMORY_SCOPE_AGENT);
        bc[1] = idx < 768u ? (int)ord[idx] : -1; }
    __syncthreads();
    for (;;) {
        const int enc = bc[1];
        if (enc < 0) break;
#if TS_SEL == 14
        const unsigned long long tu0_ = __builtin_amdgcn_s_memrealtime();
#endif
        if (enc & 0x8000) { if (ATT_ONLY & 1) attn_unit<true>(F, (enc >> 8) & 3, enc & 255, lds); } else { if (ATT_ONLY & 2) attn_unit<false>(F, (enc >> 8) & 3, enc & 255, lds); }
#if TS_SEL == 14
        if (enc == TS_ENC && F.wave == 0 && __builtin_amdgcn_mbcnt_hi(~0u, __builtin_amdgcn_mbcnt_lo(~0u, 0u)) == 0u) { asm volatile("s_waitcnt vmcnt(0)" ::: "memory"); __hip_atomic_store((unsigned*)(F.ctl + 20200), (unsigned)(__builtin_amdgcn_s_memrealtime() - tu0_), __ATOMIC_RELAXED, __HIP_MEMORY_SCOPE_AGENT); }
#endif
    }
    __syncthreads();
}
#undef SBAR
}
__global__ void __launch_bounds__(512, 2) mk_fwd(mk::Args args) {
    using namespace mk;
    extern __shared__ __attribute__((aligned(16))) unsigned char lds[];
    Frame F;
    F.lds = (LAS unsigned char*)lds; F.MISC = (volatile LAS unsigned*)(F.lds + MISC_OFF);
    F.tid = threadIdx.x; F.lane = F.tid & 63; F.wave = __builtin_amdgcn_readfirstlane(F.tid >> 6);
    F.G = gridDim.x; { const int bx = blockIdx.x; F.vcu = (F.G % 8 == 0) ? (bx % 8) * (F.G / 8) + bx / 8 : bx; }
    unsigned char* ws = args.ws; F.ws = ws; F.ctl = (gu32*)(ws + WS_CTL);
    F.x = (const float*)args.in[0]; F.c = (const float*)args.in[1]; F.pos = (const int*)args.in[2]; F.rel_bias = (const float*)args.in[3];
    F.ada_w = (const float*)args.in[4]; F.ada_b = (const float*)args.in[5]; F.norm_g = (const float*)args.in[6]; F.w_in = (const float*)args.in[7];
    F.dqn = (const float*)args.in[8]; F.dkn = (const float*)args.in[9]; F.dlam = (const float*)args.in[10]; F.dsub = (const float*)args.in[11];
    F.qan = (const float*)args.in[12]; F.kvan = (const float*)args.in[13]; F.w_uq = (const float*)args.in[14]; F.w_uk = (const float*)args.in[15];
    F.w_uv = (const float*)args.in[16]; F.mqn = (const float*)args.in[17]; F.mkn = (const float*)args.in[18]; F.w_out = (const float*)args.in[19];
    F.out = args.out;
    F.MODP = (float*)(ws + WS_MODP); F.MODF = (float*)(ws + WS_MODF); F.ROPE = (float*)(ws + WS_ROPE); F.CQ = (bf16*)(ws + WS_CQ); F.CKV = (bf16*)(ws + WS_CKV); F.KR = (bf16*)(ws + WS_KR);
    F.BT1 = (bf16*)(ws + WS_BT1); F.BT3 = (bf16*)(ws + WS_BT3); F.WUQT = (bf16*)(ws + WS_WUQT); F.WUKT = (bf16*)(ws + WS_WUKT); F.WUVT = (bf16*)(ws + WS_WUVT);
    F.XN = (bf16*)(ws + WS_XN); F.A3 = (bf16*)(ws + WS_XN); F.DQ = (bf16*)(ws + WS_DQ); F.DK = (bf16*)(ws + WS_DK); F.DV = (bf16*)(ws + WS_DV); F.SG = (bf16*)(ws + WS_SG);
    F.QM = (bf16*)(ws + WS_QM); F.KM = (bf16*)(ws + WS_KM); F.VM = (bf16*)(ws + WS_VM);
    for (int u = F.tid; u < (LDS_BYTES - LDSCTL_OFF) / 4; u += NWAVES * 64) ((LAS unsigned*)(F.lds + LDSCTL_OFF))[u] = 0u;
    __syncthreads();
    XcdBarrier bar = xcd_barrier_post((unsigned*)(F.ctl + CW_BAR) + args.li * XCD_BAR_WORDS, F.MISC + 8); bar.wave = F.wave;
    const int lo = args.ph_lo, hi = args.ph_hi;
#ifndef TS_SEL
#define TS_SEL 0
#endif
#ifndef TS_A
#define TS_A 0
#define TS_B 1
#endif
#ifndef TS_WHAT
#define TS_WHAT 0
#endif
#ifndef TS_SCALE
#define TS_SCALE 1.0f
#endif
    unsigned long long ts_[7]; int nts_ = 0;
#if TS_SEL == 12
    unsigned long long cy_[7];
#define STAMP() do { ts_[nts_] = __builtin_amdgcn_s_memrealtime(); cy_[nts_] = __builtin_amdgcn_s_memtime(); ++nts_; } while (0)
#else
#define STAMP() do { if (TS_SEL) { ts_[nts_] = __builtin_amdgcn_s_memrealtime(); } ++nts_; } while (0)
#endif
    STAMP();
#define IN(k) (lo <= (k) && (k) < hi)
#ifndef PH_MASK
#define PH_MASK 63
#endif
#define PHM(k) (((PH_MASK) >> (k)) & 1)
    if (PHM(0) && IN(0)) { p0_prologue(F); p0_rope_table(F); if (IN(1)) xcd_barrier(bar); }
    STAMP();
    if (PHM(1) && IN(1)) { p0b_xn(F); if (IN(2)) xcd_barrier(bar); }
    STAMP();
    if (PHM(2) && IN(2)) {
        pg8::Gemm g{F.XN, F.BT1, S, NINP, DM}; pg8::StaticOrder So; So.init(S, NINP, F.G, (int)blockIdx.x);
        Epi1 E{F.DQ, F.DK, F.DV, F.SG, F.CQ, F.CKV, F.KR, F.dqn, F.dkn};
        pg8::gemm_phase<Epi1, pg8::StaticOrder, true, true>(F.lds, g, So, E, F.wave);
        if (IN(3)) { p1b_prefetch(F); xcd_barrier(bar); }
    }
    STAMP();
    if (PHM(3) && IN(3)) { p1b_phase(F); if (IN(4)) xcd_barrier(bar); }
    STAMP();
#ifdef SYNTH
    if (PHM(4) && IN(4)) {
        f32x16 acc_ = {}; bf16x8 a_ = {1, 2, 3, 4, 5, 6, 7, 8}, b_ = {8, 7, 6, 5, 4, 3, 2, 1}; float v_[8];
#pragma unroll
        for (int q = 0; q < 8; ++q) v_[q] = (float)(F.lane + q);
        for (int it = 0; it < 10000; ++it) {
            acc_ = __builtin_amdgcn_mfma_f32_32x32x16_bf16(a_, b_, acc_, 0, 0, 0);
#pragma unroll
            for (int q = 0; q < SYNTH_N; ++q) { if (SYNTH_K == 0) asm volatile("v_add_f32 %0, %0, %1" : "+v"(v_[q & 7]) : "v"(1.0f)); else asm volatile("v_exp_f32 %0, %0" : "+v"(v_[q & 7])); }
            __builtin_amdgcn_sched_barrier(0);
        }
        float sink_ = acc_[0]; for (int q = 0; q < 8; ++q) sink_ += v_[q];
        if (sink_ == 123.456f) F.MODF[3073] = sink_;
        __syncthreads();
#else
    if (PHM(4) && IN(4)) { attn_phase(F);
#endif
#if TS_SEL == 9
        if (F.wave == 0 && __builtin_amdgcn_mbcnt_hi(~0u, __builtin_amdgcn_mbcnt_lo(~0u, 0u)) == 0u) { const unsigned tnow = (unsigned)(__builtin_amdgcn_s_memrealtime() - ts_[0]); atomicMax((unsigned*)(F.ctl + 20000), 0x40000000u - tnow); atomicMax((unsigned*)(F.ctl + 20064), tnow + 1u); __hip_atomic_fetch_add((unsigned*)(F.ctl + 20128), tnow / 256u, __ATOMIC_RELAXED, __HIP_MEMORY_SCOPE_AGENT); }
#endif
#ifndef FUSE_P3
        if (IN(5)) xcd_barrier(bar);
#endif
    }
    STAMP();
    if (PHM(5) && IN(5)) {
        pg8::Gemm g{F.A3, F.BT3, S, DM, DM}; Epi3 E{F.x, F.out, F.MODF + 2048};
#ifdef FUSE_P3
        volatile int* tq = (volatile int*)(F.lds + 131072 + 16);
        for (;;) {
            __syncthreads();
            if (F.wave == 0 && __builtin_amdgcn_mbcnt_hi(~0u, __builtin_amdgcn_mbcnt_lo(~0u, 0u)) == 0u) {
                const unsigned idx = __hip_atomic_fetch_add(F.ctl + CW_P3Q, 1u, __ATOMIC_RELAXED, __HIP_MEMORY_SCOPE_AGENT);
                if (idx < 256u) { unsigned* dn = (unsigned*)(F.ctl + CW_DONE + 16 * (63 - (int)(idx >> 2)));
                    XB_SPIN(xb_ld(dn) < 12u, bar.bar);
                    __builtin_amdgcn_fence(__ATOMIC_ACQUIRE, "agent"); asm volatile("s_waitcnt vmcnt(0)" ::: "memory"); }
                tq[0] = idx < 256u ? (int)idx : -1; }
            __syncthreads();
            const int ti = tq[0];
            if (ti < 0) break;
            pg8::FixedOrder So{63 - (ti >> 2), ti & 3};
            pg8::gemm_phase<Epi3, pg8::FixedOrder, true, true>(F.lds, g, So, E, F.wave);
        }
#else
        pg8::StaticOrder So; So.init(S, DM, F.G, (int)blockIdx.x);
        pg8::gemm_phase<Epi3, pg8::StaticOrder, true, true>(F.lds, g, So, E, F.wave);
#endif
    }
    STAMP();
    if (TS_SEL) { asm volatile("s_waitcnt vmcnt(0)" ::: "memory"); __syncthreads();
        if (blockIdx.x == 0 && F.wave == 0 && __builtin_amdgcn_mbcnt_hi(~0u, __builtin_amdgcn_mbcnt_lo(~0u, 0u)) == 0u) { const int a_ = (TS_SEL == 1) ? 0 : (TS_SEL > 5 ? 0 : TS_SEL), b_ = (TS_SEL > 5 ? 1 : TS_SEL + 1); float T_ = (float)(ts_[b_] - ts_[a_]) * 0.01f;
#if TS_SEL == 12
            T_ = (float)(cy_[TS_B] - cy_[TS_A]) / (float)(ts_[TS_B] - ts_[TS_A]) * 10.0f;
#endif
#if TS_SEL == 14
            T_ = (float)__hip_atomic_load((unsigned*)(F.ctl + 20200), __ATOMIC_RELAXED, __HIP_MEMORY_SCOPE_AGENT) * 0.01f;
#endif
#if TS_SEL == 13
            T_ = (float)(ts_[TS_B] - ts_[TS_A]) * 0.01f;
#endif
#if TS_SEL == 10
            { volatile LAS unsigned long long* st_ = (volatile LAS unsigned long long*)(F.lds + MISC_OFF + 64); T_ = (float)(st_[TS_B] - st_[TS_A]) * 0.01f; }
#endif
#if TS_SEL == 9
            { const unsigned mn = 0x40000000u - __hip_atomic_load((unsigned*)(F.ctl + 20000), __ATOMIC_RELAXED, __HIP_MEMORY_SCOPE_AGENT), mx = __hip_atomic_load((unsigned*)(F.ctl + 20064), __ATOMIC_RELAXED, __HIP_MEMORY_SCOPE_AGENT), sm = __hip_atomic_load((unsigned*)(F.ctl + 20128), __ATOMIC_RELAXED, __HIP_MEMORY_SCOPE_AGENT);
              T_ = (TS_WHAT == 0) ? (float)(mx - mn) * 0.01f : (TS_WHAT == 1 ? ((float)mx - (float)sm) * 0.01f : ((float)sm - (float)mn) * 0.01f); }
#endif
#ifdef TS_OFF
            T_ = T_ > TS_OFF ? T_ - TS_OFF : 0.f;
#endif
#ifdef TS_QUANT
            T_ = TS_QUANT * floorf(T_ / TS_QUANT + 0.5f);
#endif
            F.out[0] = F.x[0] + T_ * TS_SCALE; } }
#undef IN
}
static int mk_grid = 0;
static void mk_launch(void* const* d_in, void* d_out, void* d_ws, hipStream_t stream, int ph_lo, int ph_hi, int li) {
    using namespace mk;
    if (mk_grid == 0) {
        int dev = 0, cus = 0;
        if (hipGetDevice(&dev) != hipSuccess || hipDeviceGetAttribute(&cus, hipDeviceAttributeMultiprocessorCount, dev) != hipSuccess) { fprintf(stderr, "kernel_launch: device query failed\n"); mk_grid = -1; return; }
        if (hipFuncSetAttribute((const void*)mk_fwd, hipFuncAttributeMaxDynamicSharedMemorySize, LDS_BYTES) != hipSuccess) { fprintf(stderr, "kernel_launch: hipFuncSetAttribute failed\n"); mk_grid = -1; return; }
        int per_cu = 0; (void)hipOccupancyMaxActiveBlocksPerMultiprocessor(&per_cu, (const void*)mk_fwd, NWAVES * 64, LDS_BYTES); (void)hipGetLastError();
        if (per_cu < 1) fprintf(stderr, "kernel_launch: note: occupancy query reports %d blocks per CU\n", per_cu);
        mk_grid = cus;
    }
    if (mk_grid < 0) return;
    if (li == 0) (void)hipMemsetAsync((char*)d_ws + WS_CTL, 0, 128 * 1024, stream);
    Args a{}; for (int i = 0; i < 20; ++i) a.in[i] = d_in[i]; a.out = (float*)d_out; a.ws = (unsigned char*)d_ws;
    a.ph_lo = ph_lo; a.ph_hi = ph_hi; a.li = li; a.pad = 0;
    hipLaunchKernelGGL(mk_fwd, dim3(mk_grid), dim3(NWAVES * 64), LDS_BYTES, stream, a);
    const hipError_t le = hipPeekAtLastError();
    if (le != hipSuccess) fprintf(stderr, "kernel_launch: launch failed: %s\n", hipGetErrorName(le));
}
extern "C" void kernel_launch(void* const* d_in, const int* in_sizes, int n_in, void* d_out, int out_size, void* d_ws, size_t ws_size, hipStream_t stream) {
    mk_launch(d_in, d_out, d_ws, stream, 0, 6, 0);
}
```

```cpp
#include <hip/hip_runtime.h>
#include <hip/hip_bf16.h>
#include <cstdio>
#include <cstdint>
namespace pg8 {
#define PG8_LAS __attribute__((address_space(3)))
typedef unsigned short bf16_t;
typedef short bf16x8 __attribute__((ext_vector_type(8)));
typedef float f32x4 __attribute__((ext_vector_type(4)));
typedef unsigned u32x4 __attribute__((ext_vector_type(4)));
constexpr int BM = 256, BK = 64, HALF = 128, HTB = HALF * BK * 2  , STAGE_BYTES = 8 * HTB, NXCD = 8, WGM = 8;

__host__ __device__ __forceinline__ int lds_byte(int r, int c) { const int st = (r >> 4) * 2 + (c >> 5), rr = r & 15, cc = c & 31, ob = rr * 64 + cc * 2; return st * 1024 + (ob ^ (((ob >> 9) & 1) << 5)); }
__host__ __device__ __forceinline__ void stage_rc(int b, int& R, int& C) { const int st = b / 1024, sb = b % 1024, swz = sb ^ (((sb >> 9) & 1) << 5); R = (st >> 1) * 16 + swz / 64; C = (st & 1) * 32 + (swz % 64) / 2; }
__host__ __device__ __forceinline__ int perm32(int rho) { const int n = rho >> 4, i = rho & 15; return 8 * (i >> 2) + 4 * n + (i & 3); }

struct Unit { int pm, pn; };
struct Gemm { const bf16_t* A; const bf16_t* Bt; int M, N, K; };

struct StaticOrder {
    int nM, nN, nwg, G, c;
    __host__ __device__ void init(int M, int N, int G_, int c_) { nM = M / BM; nN = N / BM; nwg = nM * nN; G = G_; c = c_; }
    __host__ __device__ bool next(int i, Unit& u) const {
        const long L = (long)i * G + c; if (L >= nwg) return false;
        int wgid = (int)L; { const int q = nwg / NXCD, r = nwg % NXCD, xcd = wgid % NXCD, off = wgid / NXCD; wgid = (xcd < r ? xcd * (q + 1) : r * (q + 1) + (xcd - r) * q) + off; }
        const int nig = WGM * nN, gid = wgid / nig, fm = gid * WGM, gsz = (nM - fm) < WGM ? (nM - fm) : WGM;
        u.pm = fm + ((wgid % nig) % gsz); u.pn = (wgid % nig) / gsz; return true;
    }
    __device__ __forceinline__ void a_ready(const Unit&) const {}
    __device__ __forceinline__ void done(const Unit&) const {}
};
struct FixedOrder {
    int pm, pn;
    __device__ __forceinline__ bool next(int i, Unit& u) const { if (i != 0) return false; u.pm = pm; u.pn = pn; return true; }
    __device__ __forceinline__ void a_ready(const Unit&) const {}
    __device__ __forceinline__ void done(const Unit&) const {}
};
__device__ __forceinline__ unsigned cvt_pk_bf16(float lo, float hi) { unsigned r; asm volatile("v_cvt_pk_bf16_f32 %0, %1, %2" : "=v"(r) : "v"(lo), "v"(hi)); return r; }
typedef float f32x2 __attribute__((ext_vector_type(2)));
template <class Epi, class Sched, bool ALIGN_EPI = false, bool SP2 = false>
__device__ __forceinline__ void gemm_phase(PG8_LAS unsigned char* lds, const Gemm g, const Sched& S, const Epi& E, const int wave_sgpr) {
    const int lane = (int)__builtin_amdgcn_mbcnt_hi(~0u, __builtin_amdgcn_mbcnt_lo(~0u, 0u)), wid = wave_sgpr, tid = wid * 64 + lane, wr = wid >> 2, wc = wid & 3, fr = lane & 15, fq = lane >> 4;
    const int K = g.K, nt = K / BK;
    unsigned voffA[2], voffB[2];
#pragma unroll
    for (int i = 0; i < 2; ++i) { int R, C; stage_rc(tid * 16 + i * 8192, R, C); const int Rb = Epi::PERM ? ((R & ~31) + perm32(R & 31)) : R;
        voffA[i] = (unsigned)(R * K + C) * 2u; voffB[i] = (unsigned)(Rb * K + C) * 2u; }
    const size_t kstep = (size_t)(BK * 2);
    const size_t hstep = (size_t)HALF * K * 2;
    const size_t tstep = 2 * hstep;
    const unsigned ldsw = (unsigned)wid * 1024u;
    const int aoff = lds_byte(wr * 64 + fr, fq * 8), boff = lds_byte(wc * 32 + fr, fq * 8);
#define PG8_SA(b, h) (((b) * 2 + (h)) * HTB)
#define PG8_SB(b, h) ((4 + (b) * 2 + (h)) * HTB)
#define PG8_STAGE(bufoff, gbase, voff) do { _Pragma("unroll") for (int _i = 0; _i < 2; ++_i) \
        __builtin_amdgcn_global_load_lds((const unsigned*)((const char*)(gbase) + (voff)[_i]), (PG8_LAS unsigned*)(lds + (bufoff) + ldsw + _i * 8192), 16, 0, 0); } while (0)
#define PG8_LDA(dst, b, h) do { _Pragma("unroll") for (int m = 0; m < 4; ++m) _Pragma("unroll") for (int k = 0; k < 2; ++k) dst[m][k] = *(const PG8_LAS bf16x8*)(lds + PG8_SA(b, h) + aoff + m * 2048 + k * 1024); } while (0)
#define PG8_LDB(dst, b, h) do { _Pragma("unroll") for (int n = 0; n < 2; ++n) _Pragma("unroll") for (int k = 0; k < 2; ++k) dst[n][k] = *(const PG8_LAS bf16x8*)(lds + PG8_SB(b, h) + boff + n * 2048 + k * 1024); } while (0)
#define PG8_MMA(ai, bj, At, Bt) do { __builtin_amdgcn_s_setprio(1); _Pragma("unroll") for (int m = 0; m < 4; ++m) _Pragma("unroll") for (int n = 0; n < 2; ++n) _Pragma("unroll") for (int k = 0; k < 2; ++k) \
        acc[ai][bj][m][n] = __builtin_amdgcn_mfma_f32_16x16x32_bf16(Bt[n][k], At[m][k], acc[ai][bj][m][n], 0, 0, 0); __builtin_amdgcn_s_setprio(0); } while (0)
#define PG8_WAIT_V(n) asm volatile("s_waitcnt vmcnt(" #n ")" ::: "memory")
#define PG8_WAIT_L(n) asm volatile("s_waitcnt lgkmcnt(" #n ")" ::: "memory")
#define PG8_BAR __builtin_amdgcn_s_barrier()
#define PG8_SCHED __builtin_amdgcn_sched_barrier(0)
    Unit cur, nxt; int ui = 0;
    if (!S.next(0, cur)) return;
    f32x4 acc[2][2][4][2];
#pragma unroll
    for (int a = 0; a < 2; ++a)
#pragma unroll
        for (int b = 0; b < 2; ++b)
#pragma unroll
            for (int m = 0; m < 4; ++m)
#pragma unroll
                for (int n = 0; n < 2; ++n) acc[a][b][m][n] = (f32x4){0.f, 0.f, 0.f, 0.f};
    bf16x8 At[4][2], B0[2][2], B1[2][2];
    const char* cA = (const char*)g.A + (size_t)cur.pm * tstep; const char* cB = (const char*)g.Bt + (size_t)cur.pn * tstep;
    S.a_ready(cur);
    if constexpr (SP2) {
        PG8_STAGE(PG8_SB(0, 0), cB, voffB); PG8_STAGE(PG8_SB(0, 1), cB + hstep, voffB); PG8_STAGE(PG8_SA(0, 0), cA, voffA); PG8_STAGE(PG8_SA(0, 1), cA + hstep, voffA);
        if (wr == 1) PG8_BAR;
        PG8_WAIT_V(2); PG8_BAR;
        PG8_STAGE(PG8_SB(1, 0), cB + kstep, voffB); PG8_STAGE(PG8_SA(1, 0), cA + kstep, voffA); PG8_STAGE(PG8_SB(1, 1), cB + hstep + kstep, voffB);
        PG8_WAIT_V(6); PG8_BAR;
    } else {
        PG8_STAGE(PG8_SB(0, 0), cB, voffB); PG8_STAGE(PG8_SA(0, 0), cA, voffA); PG8_STAGE(PG8_SB(0, 1), cB + hstep, voffB); PG8_STAGE(PG8_SA(0, 1), cA + hstep, voffA);
        if (wr == 1) PG8_BAR;
        PG8_WAIT_V(4); PG8_BAR;
        PG8_STAGE(PG8_SB(1, 0), cB + kstep, voffB); PG8_STAGE(PG8_SA(1, 0), cA + kstep, voffA); PG8_STAGE(PG8_SB(1, 1), cB + hstep + kstep, voffB);
        PG8_WAIT_V(6); PG8_BAR;
    }
    for (;;) {
        const bool has_next = S.next(ui + 1, nxt);
        const char* nA = has_next ? (const char*)g.A + (size_t)nxt.pm * tstep : cA; const char* nB = has_next ? (const char*)g.Bt + (size_t)nxt.pn * tstep : cB;
        for (int t = 0; t < nt; t += 2) {
            const bool last = (t == nt - 2);
            const char* a1 = cA + (size_t)(t + 1) * kstep;
            const char* a2 = last ? nA : cA + (size_t)(t + 2) * kstep; const char* b2 = last ? nB : cB + (size_t)(t + 2) * kstep;
            const char* a3 = a2 + kstep; const char* b3 = b2 + kstep;
            if (last && has_next) S.a_ready(nxt);
            if constexpr (SP2) {
            PG8_LDB(B0, 0, 0); PG8_LDB(B1, 0, 1); PG8_SCHED; PG8_LDA(At, 0, 0); PG8_STAGE(PG8_SA(1, 1), a1 + hstep, voffA);
            PG8_WAIT_V(8); PG8_WAIT_L(0); PG8_BAR; PG8_MMA(0, 0, At, B0); PG8_MMA(0, 1, At, B1); PG8_BAR; PG8_SCHED;
            PG8_LDA(At, 0, 1); PG8_STAGE(PG8_SB(0, 0), b2, voffB); PG8_STAGE(PG8_SB(0, 1), b2 + hstep, voffB); PG8_STAGE(PG8_SA(0, 0), a2, voffA);
            PG8_WAIT_V(8); PG8_WAIT_L(0); PG8_BAR; PG8_MMA(1, 0, At, B0); PG8_MMA(1, 1, At, B1); PG8_BAR; PG8_SCHED;
            PG8_LDB(B0, 1, 0); PG8_LDB(B1, 1, 1); PG8_SCHED; PG8_LDA(At, 1, 0); PG8_STAGE(PG8_SA(0, 1), a2 + hstep, voffA);
            PG8_WAIT_V(8); PG8_WAIT_L(0); PG8_BAR; PG8_MMA(0, 0, At, B0); PG8_MMA(0, 1, At, B1); PG8_BAR; PG8_SCHED;
            PG8_LDA(At, 1, 1); PG8_STAGE(PG8_SB(1, 0), b3, voffB); PG8_STAGE(PG8_SB(1, 1), b3 + hstep, voffB); PG8_STAGE(PG8_SA(1, 0), a3, voffA);
            PG8_WAIT_V(8); PG8_WAIT_L(0); PG8_BAR; PG8_MMA(1, 0, At, B0); PG8_MMA(1, 1, At, B1); PG8_BAR; PG8_SCHED;
            } else {
            PG8_LDB(B0, 0, 0); PG8_SCHED; PG8_LDA(At, 0, 0); PG8_STAGE(PG8_SA(1, 1), a1 + hstep, voffA);
            PG8_WAIT_L(8); PG8_BAR; PG8_WAIT_L(0); PG8_MMA(0, 0, At, B0); PG8_BAR; PG8_SCHED;
            PG8_LDB(B1, 0, 1); PG8_STAGE(PG8_SB(0, 0), b2, voffB);
            PG8_BAR; PG8_WAIT_L(0); PG8_MMA(0, 1, At, B1); PG8_BAR;
            PG8_LDA(At, 0, 1); PG8_STAGE(PG8_SA(0, 0), a2, voffA);
            PG8_BAR; PG8_WAIT_L(0); PG8_MMA(1, 0, At, B0); PG8_BAR; PG8_SCHED;
            PG8_STAGE(PG8_SB(0, 1), b2 + hstep, voffB);
            PG8_WAIT_V(6); PG8_BAR; PG8_MMA(1, 1, At, B1); PG8_BAR;
            PG8_LDB(B0, 1, 0); PG8_SCHED; PG8_LDA(At, 1, 0); PG8_STAGE(PG8_SA(0, 1), a2 + hstep, voffA);
            PG8_WAIT_L(8); PG8_BAR; PG8_WAIT_L(0); PG8_MMA(0, 0, At, B0); PG8_BAR; PG8_SCHED;
            PG8_LDB(B1, 1, 1); PG8_STAGE(PG8_SB(1, 0), b3, voffB);
            PG8_BAR; PG8_WAIT_L(0); PG8_MMA(0, 1, At, B1); PG8_BAR;
            PG8_LDA(At, 1, 1); PG8_STAGE(PG8_SA(1, 0), a3, voffA);
            PG8_BAR; PG8_WAIT_L(0); PG8_MMA(1, 0, At, B0); PG8_BAR; PG8_SCHED;
            PG8_STAGE(PG8_SB(1, 1), b3 + hstep, voffB);
            PG8_WAIT_V(6); PG8_BAR; PG8_MMA(1, 1, At, B1); PG8_BAR;
            }
        }
        if constexpr (ALIGN_EPI) { if (wr == 0) PG8_BAR; }
        if constexpr (!Epi::AFTER_DRAIN) { E(acc, cur, wr, wc, fr, fq); S.done(cur); }
        if (!has_next) break;
#pragma unroll
        for (int a = 0; a < 2; ++a)
#pragma unroll
            for (int b = 0; b < 2; ++b)
#pragma unroll
                for (int m = 0; m < 4; ++m)
#pragma unroll
                    for (int n = 0; n < 2; ++n) acc[a][b][m][n] = (f32x4){0.f, 0.f, 0.f, 0.f};
        cur = nxt; cA = nA; cB = nB; ++ui;
        if constexpr (ALIGN_EPI) { if (wr == 1) PG8_BAR; }
    }
    PG8_WAIT_V(0);
    if constexpr (!ALIGN_EPI) { if (wr == 0) PG8_BAR; }
    PG8_BAR;
    if constexpr (Epi::AFTER_DRAIN) { E.fused(acc, cur, wr, wc, fr, fq, lds, wid, lane); S.done(cur); }
#undef PG8_SA
#undef PG8_SB
#undef PG8_STAGE
#undef PG8_LDA
#undef PG8_LDB
#undef PG8_MMA
#undef PG8_WAIT_V
#undef PG8_WAIT_L
#undef PG8_BAR
#undef PG8_SCHED
}
}
#define GAS __attribute__((address_space(1)))
#define LAS __attribute__((address_space(3)))
typedef unsigned short bf16;
typedef unsigned v4u __attribute__((ext_vector_type(4)));
typedef float f32x4 __attribute__((ext_vector_type(4)));
typedef short bf16x8 __attribute__((ext_vector_type(8)));
typedef GAS unsigned gu32;
typedef GAS unsigned long long gu64;
#define RLX_AGENT __ATOMIC_RELAXED, __HIP_MEMORY_SCOPE_AGENT
#define LDS_WAIT() asm volatile("s_waitcnt lgkmcnt(0)" ::: "memory")
#define VM_WAIT() asm volatile("s_waitcnt vmcnt(0)" ::: "memory")
__device__ __forceinline__ unsigned long long rt() { return __builtin_amdgcn_s_memrealtime(); }
__device__ __forceinline__ unsigned f2bf(float f) { unsigned u = __builtin_bit_cast(unsigned, f); return (u + 0x7fffu + ((u >> 16) & 1u)) >> 16; }
__device__ __forceinline__ unsigned pk2(float lo, float hi) { return f2bf(lo) | (f2bf(hi) << 16); }

#define XB_TMO      128
#define XB_XCNT(j)  (256  + 64 * (j))
#define XB_XSUB(j)  (1280 + 64 * (j))
#define XB_XGEN(j)  (2304 + 64 * (j))
#define XB_TOP      3328
#define XB_TOPGEN   3392
#define XCD_BAR_WORDS 3456
#define XB_SPIN_CAP (1u << 18)

__device__ __forceinline__ unsigned xb_ld(unsigned* p)              { return __hip_atomic_load(p, __ATOMIC_RELAXED, __HIP_MEMORY_SCOPE_AGENT); }
__device__ __forceinline__ unsigned xb_add(unsigned* p, unsigned v) { return __hip_atomic_fetch_add(p, v, __ATOMIC_RELAXED, __HIP_MEMORY_SCOPE_AGENT); }
__device__ __forceinline__ unsigned xb_xcc_id() { return (unsigned)__builtin_amdgcn_s_getreg((3 << 11) | 20) & 0xFu; }
#define XB_SPIN(cond, bar) do { unsigned _sp = 0; while (cond) { __builtin_amdgcn_s_sleep(1); \
    if ((++_sp & 255u) == 0u) { if (xb_ld(&(bar)[XB_TMO])) break; if (_sp > XB_SPIN_CAP) { atomicAdd(&(bar)[XB_TMO], 1u); break; } } } } while (0)

struct XcdBarrier {
    unsigned* bar; unsigned x; int wave;
    volatile LAS unsigned* st;
};

__device__ __forceinline__ XcdBarrier xcd_barrier_post(unsigned* bar, volatile LAS unsigned* st) {
    XcdBarrier b; b.bar = bar; b.x = xb_xcc_id(); b.st = st;
    if (threadIdx.x == 0) (void)xb_add(&bar[XB_XCNT(b.x)], 1u);
    return b;
}
__device__ __forceinline__ void xcd_barrier_complete(unsigned* bar, unsigned x, unsigned& nloc, unsigned& nx) {
    const unsigned G = gridDim.x * gridDim.y * gridDim.z;
    unsigned sum, cnt, mine, sp = 0u;
    for (;;) {
        sum = 0u; cnt = 0u; mine = 0u;
#pragma unroll
        for (unsigned j = 0; j < 16; ++j) { const unsigned c = xb_ld(&bar[XB_XCNT(j)]); sum += c; cnt += (c > 0u) ? 1u : 0u; mine = (j == x) ? c : mine; }
        if (sum == G) break;
        __builtin_amdgcn_s_sleep(1);
        if ((++sp & 255u) == 0u) { if (xb_ld(&bar[XB_TMO])) break; if (sp > XB_SPIN_CAP) { atomicAdd(&bar[XB_TMO], 1u); break; } }
    }
    nloc = mine > 0u ? mine : 1u; nx = cnt > 0u ? cnt : 1u;
}

__device__ __forceinline__ void xcd_barrier(const XcdBarrier& b) {
    asm volatile("s_waitcnt vmcnt(0)" ::: "memory");
    __syncthreads();
    if (b.wave == 0 && __builtin_amdgcn_mbcnt_hi(~0u, __builtin_amdgcn_mbcnt_lo(~0u, 0u)) == 0u) {
        unsigned* bar = b.bar;
        __builtin_amdgcn_s_waitcnt(0);
        unsigned nloc = b.st[0], nx = b.st[1];
        if (nloc == 0u) { xcd_barrier_complete(bar, b.x, nloc, nx); b.st[0] = nloc; b.st[1] = nx; }
        const unsigned old = xb_add(&bar[XB_XSUB(b.x)], 1u);
        const unsigned gen = old / nloc;
        if (old + 1u == (gen + 1u) * nloc) {
            __builtin_amdgcn_fence(__ATOMIC_RELEASE, "agent");
            asm volatile("s_waitcnt vmcnt(0)" ::: "memory");
            const unsigned og = xb_add(&bar[XB_TOP], 1u);
            const unsigned tg = og / nx;
            if (og + 1u == (tg + 1u) * nx) xb_add(&bar[XB_TOPGEN], 1u);
            else XB_SPIN(xb_ld(&bar[XB_TOPGEN]) == tg, bar);
            __builtin_amdgcn_fence(__ATOMIC_ACQUIRE, "agent");
            xb_add(&bar[XB_XGEN(b.x)], 1u);
            asm volatile("s_waitcnt vmcnt(0)" ::: "memory");
        } else {
            XB_SPIN(xb_ld(&bar[XB_XGEN(b.x)]) == gen, bar);
            __builtin_amdgcn_fence(__ATOMIC_ACQUIRE, "agent");
            asm volatile("s_waitcnt vmcnt(0)" ::: "memory");
        }
    }
    __syncthreads();
}
namespace mk {
constexpr int S = 16384, DM = 1024, NIN = 3008, NINP = 3072, NWAVES = 8;
constexpr float RMS_EPS = 1e-6f, LOG2E = 1.4426950408889634f;
constexpr float DIFF_C = 0.125f * LOG2E;
constexpr float MLA_C = 0.07216878364870323f * LOG2E;
constexpr size_t MiB = 1u << 20;
constexpr size_t WS_CTL = 0, CTL_ZERO_BYTES = 1 * MiB;
constexpr size_t WS_MODP = 1 * MiB;
constexpr size_t WS_MODF = 1 * MiB + 512 * 1024;
constexpr size_t WS_BT1 = 2 * MiB, WS_BT3 = 8 * MiB;
constexpr size_t WS_WUQT = 10 * MiB, WS_WUKT = 10 * MiB + 512 * 1024, WS_WUVT = 10 * MiB + 768 * 1024;
constexpr size_t WS_XN = 12 * MiB;
constexpr size_t WS_DQ = 44 * MiB, WS_DK = 60 * MiB, WS_DV = 76 * MiB;
constexpr size_t WS_CQ = 92 * MiB, WS_CKV = 108 * MiB, WS_KR = 116 * MiB;
constexpr size_t WS_SG = 120 * MiB;
constexpr size_t WS_QM = 152 * MiB, WS_KM = 176 * MiB, WS_VM = 200 * MiB;
constexpr size_t WS_ROPE = 216 * MiB;
constexpr size_t WS_END = 220 * MiB;
constexpr int CW_BAR = 4096;
constexpr int CW_QUEUE = 16384;
#ifndef FUSE_P3
#define FUSE_P3 1
#endif
constexpr int CW_DONE = 18432;
constexpr int CW_P3Q = 19968;
constexpr int RING_BYTES = 131072, LDSCTL_OFF = 160 * 1024 - 512, MISC_OFF = LDSCTL_OFF + 320, LDS_BYTES = 160 * 1024;

typedef float f32x16 __attribute__((ext_vector_type(16)));
typedef short s16x4 __attribute__((ext_vector_type(4)));
typedef unsigned u32x2 __attribute__((ext_vector_type(2)));

struct Args { const void* in[20]; float* out; unsigned char* ws; int ph_lo, ph_hi, li, pad; };

__device__ __forceinline__ unsigned cvtpk(float lo, float hi) { unsigned r; asm volatile("v_cvt_pk_bf16_f32 %0, %1, %2" : "=v"(r) : "v"(lo), "v"(hi)); return r; }
__device__ __forceinline__ float bf2f(unsigned short b) { return __uint_as_float((unsigned)b << 16); }
__device__ __forceinline__ float silu_f(float v) { return v / (1.f + __expf(-v)); }
__device__ __forceinline__ float silu_g(float v) { return v * __builtin_amdgcn_rcpf(1.f + __builtin_amdgcn_exp2f(v * -1.4426950408889634f)); }
__device__ __forceinline__ float wave_sum(float v) {
#pragma unroll
    for (int o = 1; o < 64; o <<= 1) v += __shfl_xor(v, o);
    return v;
}
__device__ __forceinline__ float half_swap_add(float v) {
    auto rr = __builtin_amdgcn_permlane32_swap(__float_as_uint(v), __float_as_uint(v), false, false);
    return __uint_as_float(rr[0]) + __uint_as_float(rr[1]);
}
__device__ __forceinline__ int crow(int r, int hi) { return (r & 3) + 8 * (r >> 2) + 4 * hi; }
__host__ __device__ __forceinline__ int rowperm(int n) {
    const int pn = n >> 8, q = n & 255, wc = q >> 6, j = q & 63, bj = j >> 5, fq = (j >> 3) & 3, nn = (j >> 2) & 1, e = j & 3;
    return (pn << 8) + 128 * bj + 32 * wc + 16 * nn + 4 * fq + e;
}
__host__ __device__ __forceinline__ int rowperm3(int n) {
    const int pn = n >> 8, q = n & 255, wc = q >> 6, j = q & 63, bj = j >> 5, nn = (j >> 4) & 1, fq = (j >> 2) & 3, e = j & 3;
    return (pn << 8) + 128 * bj + 32 * wc + 16 * nn + 4 * fq + e;
}
__device__ const double INVF[32] = {1.0, 0.7498942093324559, 0.5623413251903491, 0.4216965034285822, 0.31622776601683794, 0.23713737056616552, 0.1778279410038923, 0.1333521432163324, 0.1, 0.07498942093324558, 0.05623413251903491, 0.042169650342858224, 0.03162277660168379, 0.023713737056616554, 0.01778279410038923, 0.01333521432163324, 0.01, 0.007498942093324558, 0.005623413251903491, 0.004216965034285823, 0.0031622776601683794, 0.0023713737056616554, 0.0017782794100389228, 0.001333521432163324, 0.001, 0.0007498942093324559, 0.0005623413251903491, 0.00042169650342858224, 0.00031622776601683794, 0.00023713737056616554, 0.00017782794100389227, 0.0001333521432163324};
__device__ __forceinline__ void rope_cs(float fpos, int i, float& cs, float& sn) {
    const float ang = fpos * (float)INVF[i];
    double t = (double)ang * 0.15915494309189535; t -= __builtin_rint(t);
    const float tf = (float)t; cs = __builtin_amdgcn_cosf(tf); sn = __builtin_amdgcn_sinf(tf);
}
__device__ __forceinline__ int t5_bucket(int rel) {
    const int n = rel < 0 ? -rel : rel; int b;
    if (n < 8) b = n; else { const unsigned n2 = (unsigned)n * (unsigned)n; b = 8 + (31 - __builtin_clz(n2 >> 6)); if (b > 15) b = 15; }
    return (rel > 0 ? 16 : 0) + b;
}

struct Frame {
    LAS unsigned char* lds; volatile LAS unsigned* MISC; gu32* ctl;
    int tid, lane, wave, vcu, G;
    const float *x, *c, *rel_bias, *ada_w, *ada_b, *norm_g, *w_in, *dqn, *dkn, *dlam, *dsub, *qan, *kvan, *w_uq, *w_uk, *w_uv, *mqn, *mkn, *w_out; const int* pos;
    float* out; unsigned char* ws;
    float *MODP, *MODF, *ROPE; bf16 *CQ, *CKV, *KR; bf16 *BT1, *BT3, *WUQT, *WUKT, *WUVT, *XN, *A3, *DQ, *DK, *DV, *SG, *QM, *KM, *VM;
};

template <int PERM>
__device__ __forceinline__ void p0_transpose_item(const float* W, int K, int N, bf16* WT, LAS float* scr, int item, int lane) {
    const int nblk = N / 32, kb = item / nblk, nb = item % nblk, k0 = 64 * kb, n0 = 32 * nb;
    { f32x4 w[8];
#pragma unroll
      for (int i = 0; i < 8; ++i) { const int kk = 8 * i + (lane >> 3); w[i] = *(const GAS f32x4*)(W + (size_t)(k0 + kk) * N + n0 + 4 * (lane & 7)); }
#pragma unroll
      for (int i = 0; i < 8; ++i) { LAS float* d = scr + (8 * i + (lane >> 3)) * 33 + 4 * (lane & 7); d[0] = w[i].x; d[1] = w[i].y; d[2] = w[i].z; d[3] = w[i].w; } }
    LDS_WAIT(); asm volatile("" ::: "memory");
    const int c = lane & 7;
#pragma unroll
    for (int j = 0; j < 4; ++j) { const int n = (lane >> 3) + 8 * j; const LAS float* s = scr + (8 * c) * 33 + n;
        v4u o; o.x = pk2(s[0 * 33], s[1 * 33]); o.y = pk2(s[2 * 33], s[3 * 33]); o.z = pk2(s[4 * 33], s[5 * 33]); o.w = pk2(s[6 * 33], s[7 * 33]);
        const int row = PERM == 1 ? rowperm(n0 + n) : (PERM == 2 ? rowperm3(n0 + n) : (n0 + n));
        *(GAS v4u*)(WT + (size_t)row * K + k0 + 8 * c) = o; }
    LDS_WAIT(); asm volatile("" ::: "memory");
}
__device__ const unsigned short ATT_ORD[768] = {63,319,575,831,62,318,574,830,61,317,573,829,60,316,572,828,59,315,571,827,58,314,570,826,57,313,569,825,56,312,568,824,55,311,567,823,54,310,566,822,53,309,565,821,52,308,564,820,51,307,563,819,50,306,562,818,49,305,561,817,48,304,560,816,47,303,559,815,46,302,558,814,45,301,557,813,44,300,556,812,43,299,555,811,32895,33151,33407,33663,42,298,554,810,32894,33150,33406,33662,32893,33149,33405,33661,32892,33148,33404,33660,41,297,553,809,32891,33147,33403,33659,32890,33146,33402,33658,32889,33145,33401,33657,40,296,552,808,32888,33144,33400,33656,32887,33143,33399,33655,32886,33142,33398,33654,39,295,551,807,32885,33141,33397,33653,32884,33140,33396,33652,32883,33139,33395,33651,38,294,550,806,32882,33138,33394,33650,32867,33379,32866,33378,32,544,32864,33376,32863,33375,32862,33374,32861,33373,32860,33372,32859,33371,32858,33370,32857,33369,32856,33368,32855,33367,32854,33366,32853,33365,32852,33364,32851,33363,32850,33362,32849,33361,26,538,32847,33359,32846,33358,25,537,32844,33356,32843,33355,24,792,32840,33608,33350,33093,22,790,32834,33602,33344,33087,20,788,32828,33596,32826,33594,18,786,32822,785,33331,528,32816,783,33582,526,32810,33064,268,32804,267,33313,10,33054,32796,33306,33561,263,33557,33299,517,260,771,33286,33542,33290,516,33029,773,33555,33300,519,33048,33546,33285,33562,33052,33310,266,772,33569,523,33541,33060,524,33296,33033,33320,33066,32786,782,1,33556,33325,32814,33072,784,775,33037,33587,33076,33289,33304,257,33078,274,33335,8,33082,33337,33552,33084,531,33308,276,33341,33343,513,33600,33566,33042,33090,32832,33545,278,33347,522,33293,33349,6,33606,32800,33096,32838,769,280,33353,779,33099,33611,33100,33612,281,793,33316,33046,33102,33614,32783,33103,33615,282,794,780,32776,33105,33617,33560,33106,33618,33028,33107,33619,33108,33620,33576,33109,33621,33549,33110,33622,264,33111,33623,33298,33112,33624,33322,33113,33625,33114,33626,33284,33115,33627,33323,33116,33628,33032,33564,33117,33629,33118,33630,262,33119,33631,33581,33120,33632,33070,288,800,33122,33634,33039,9,33540,33123,33635,33328,32780,33329,33302,778,33288,16,33056,32771,33332,33554,33047,33334,33058,32881,33137,33393,33649,33027,37,293,549,805,33591,32880,33136,33392,33648,530,32879,33135,33391,33647,520,33572,32878,33134,33390,33646,33544,33295,36,292,548,804,32877,33133,33389,33645,518,32876,33132,33388,33644,33036,33593,32875,33131,33387,33643,33338,35,291,547,803,32874,33130,33386,33642,33317,32873,33129,33385,33641,33283,787,32872,33128,33384,33640,34,290,546,802,32871,33127,33383,33639,33340,32870,33126,33382,33638,33563,32869,33125,33381,33637,33,289,545,801,33597,32868,33124,33380,33636,532,33319,33539,2,32865,33121,33377,33633,33558,33599,265,33297,32831,31,287,543,799,33088,33578,33292,30,286,542,798,33346,33026,33551,33303,29,285,541,797,33603,33579,534,33311,28,284,540,796,258,33605,774,33312,33282,32837,27,283,539,795,270,33094,776,33326,32848,33104,33360,33616,33352,33538,32845,33101,33357,33613,33609,536,33314,33548,33584,32842,33098,33354,33610,33553,514,32841,33097,0,33045,33351,33607,535,791,32839,33095,33038,32794,33585,23,279,33571,32836,33092,33348,33604,272,32835,33091,33345,33601,533,789,32833,33089,256,21,277,33573,521,33559,33588,32830,33086,33342,33598,32829,33085,770,32787,33547,33339,33595,19,275,32827,33083,512,32825,33081,33590,32824,33080,33336,33592,33575,32823,33079,33589,17,273,529,33333,32821,33077,5,33294,32820,768,33567,32819,33075,33305,32818,33074,33330,33586,32817,33073,33031,33568,33327,33583,271,527,32815,33071,15,32808,33025,33301,32813,33069,14,32812,33068,33324,33580,3,32811,33067,781,33577,13,269,525,33321,32809,33065,33281,33050,32807,33063,12,32806,33062,33318,33574,33570,33043,33287,32805,33061,33315,32803,33059,33537,7,11,32802,33550,32801,33057,261,32799,33055,32798,33565,33309,32768,777,32797,33053,259,33307,32795,33051,33543,33024,32793,33049,32792,32791,32790,32789,33280,33044,32788,33041,32785,33040,32784,33536,4,33030,32782,32781,515,33291,33035,32779,33034,32778,32777,32775,32774,32773,32772,32770,32769};
#ifndef LPT_D
#define LPT_D 6
#define LPT_M 26
#endif
__device__ __forceinline__ void p0_prologue(Frame& F) {
    LAS float* scr = (LAS float*)(F.lds + F.wave * 16384);
    const int gw = F.wave * F.G + F.vcu, NGW = F.G * NWAVES, lane = F.lane;
    constexpr int I_IN = (DM / 64) * (NIN / 32), I_OUT = (DM / 64) * (DM / 32), I_UQ = (256 / 64) * (768 / 32), I_UK = (128 / 64) * (512 / 32), I_UV = I_UK;
    constexpr int I_GEMV = 16 * 12, I_PAD = 64, I_TR = I_IN + I_OUT + I_UQ + I_UK + I_UV;
    constexpr int NITEMS = I_TR + I_GEMV + I_PAD + 1;
    int gp0 = NITEMS - NGW; gp0 = gp0 < 0 ? 0 : (gp0 > NITEMS - I_GEMV ? NITEMS - I_GEMV : gp0);
    for (int it = gw; it < NITEMS; it += NGW) {
        int r; if (it >= gp0 && it < gp0 + I_GEMV) r = I_TR + (it - gp0); else { const int q = it < gp0 ? it : it - I_GEMV; r = q < I_TR ? q : q + I_GEMV; }
        if (r < I_IN) { p0_transpose_item<1>(F.w_in, DM, NIN, F.BT1, scr, r, lane); continue; } r -= I_IN;
        if (r < I_OUT) { p0_transpose_item<2>(F.w_out, DM, DM, F.BT3, scr, r, lane); continue; } r -= I_OUT;
        if (r < I_UQ) { p0_transpose_item<0>(F.w_uq, 256, 768, F.WUQT, scr, r, lane); continue; } r -= I_UQ;
        if (r < I_UK) { p0_transpose_item<0>(F.w_uk, 128, 512, F.WUKT, scr, r, lane); continue; } r -= I_UK;
        if (r < I_UV) { p0_transpose_item<0>(F.w_uv, 128, 512, F.WUVT, scr, r, lane); continue; } r -= I_UV;
        if (r < I_GEMV) {
            const int kq = r / 12, cg = r % 12; const GAS f32x4* wp = (const GAS f32x4*)(F.ada_w + (size_t)(64 * kq) * 3072 + 256 * cg) + lane;
            f32x4 acc = {0.f, 0.f, 0.f, 0.f};
            const int sl = __float_as_int(silu_f(F.c[64 * kq + lane]));
#pragma unroll
            for (int b = 0; b < 2; ++b) { f32x4 w[32];
#pragma unroll
                for (int k = 0; k < 32; ++k) w[k] = wp[(size_t)(32 * b + k) * 768];
#pragma unroll
                for (int k = 0; k < 32; ++k) acc += w[k] * __int_as_float(__builtin_amdgcn_readlane(sl, 32 * b + k)); }
            *((GAS f32x4*)(F.MODP + kq * 3072 + 256 * cg) + lane) = acc; continue; } r -= I_GEMV;
        if (r < I_PAD) { GAS v4u* p = (GAS v4u*)(F.BT1 + (size_t)rowperm(NIN + r) * DM) + 2 * lane; const v4u z = {0u, 0u, 0u, 0u}; p[0] = z; p[1] = z; continue; } r -= I_PAD;
        { unsigned short* ord = (unsigned short*)(F.MODF + 4096);
          for (int u = lane; u < 768; u += 64) ord[u] = ATT_ORD[u]; }
        if (lane == 0) { float a = 0.f, b = 0.f; for (int d = 0; d < 64; ++d) { a += F.dlam[d] * F.dlam[64 + d]; b += F.dlam[128 + d] * F.dlam[192 + d]; }
            F.MODF[3072] = expf(a) - expf(b) + 0.2f; }
    }
}
__device__ __forceinline__ void p0_rope_table(Frame& F) {
    const int gt = (F.vcu * NWAVES + F.wave) * 64 + F.lane, NT_ = F.G * NWAVES * 64;
    for (int e = gt; e < S * 32; e += NT_) { const int row = e >> 5, i = e & 31; float cs, sn; rope_cs((float)F.pos[row], i, cs, sn); F.ROPE[(size_t)row * 64 + i] = cs; F.ROPE[(size_t)row * 64 + 32 + i] = sn; }
}
__device__ __forceinline__ void p0b_xn(Frame& F) {
    LAS float* modL = (LAS float*)F.lds;
    { const int t = F.tid; f32x4 v = *(const GAS f32x4*)(F.ada_b + 4 * t);
#pragma unroll
      for (int kq = 0; kq < 16; ++kq) v += *(const GAS f32x4*)(F.MODP + kq * 3072 + 4 * t);
      *(LAS f32x4*)(modL + 4 * t) = v;
      if (blockIdx.x == 0 && t < 256) { f32x4 g = *(const GAS f32x4*)(F.ada_b + 2048 + 4 * t);
#pragma unroll
          for (int kq = 0; kq < 16; ++kq) g += *(const GAS f32x4*)(F.MODP + kq * 3072 + 2048 + 4 * t);
          *(GAS f32x4*)(F.MODF + 2048 + 4 * t) = g; } }
    __syncthreads();
    f32x4 a[4], sh[4];
#pragma unroll
    for (int j = 0; j < 4; ++j) { const int k = 4 * F.lane + 256 * j; const f32x4 g = *(const GAS f32x4*)(F.norm_g + k); const f32x4 sc = *(LAS f32x4*)(modL + 1024 + k);
        a[j] = g * (sc + 1.f); sh[j] = *(LAS f32x4*)(modL + k); }
    const int gw = F.vcu * NWAVES + F.wave, NGW = F.G * NWAVES;
    f32x4 v[4], u[4];
    if (gw < S) { const int m2 = (gw + NGW < S) ? gw + NGW : gw;
#pragma unroll
        for (int j = 0; j < 4; ++j) { v[j] = ((const GAS f32x4*)(F.x + (size_t)gw * DM) + F.lane)[64 * j]; u[j] = ((const GAS f32x4*)(F.x + (size_t)m2 * DM) + F.lane)[64 * j]; } }
    for (int m = gw; m < S; m += 2 * NGW) {
        const int m2 = (m + NGW < S) ? m + NGW : m;
        float s = 0.f, s2 = 0.f;
#pragma unroll
        for (int j = 0; j < 4; ++j) { s += (v[j].x * v[j].x + v[j].y * v[j].y) + (v[j].z * v[j].z + v[j].w * v[j].w); s2 += (u[j].x * u[j].x + u[j].y * u[j].y) + (u[j].z * u[j].z + u[j].w * u[j].w); }
        const float rinv = rsqrtf(wave_sum(s) * (1.f / DM) + RMS_EPS), rinv2 = rsqrtf(wave_sum(s2) * (1.f / DM) + RMS_EPS);
        f32x4 vn[4], un[4]; const int mn = m + 2 * NGW;
        if (mn < S) { const int mn2 = (mn + NGW < S) ? mn + NGW : mn;
#pragma unroll
            for (int j = 0; j < 4; ++j) { vn[j] = ((const GAS f32x4*)(F.x + (size_t)mn * DM) + F.lane)[64 * j]; un[j] = ((const GAS f32x4*)(F.x + (size_t)mn2 * DM) + F.lane)[64 * j]; } }
        __builtin_amdgcn_sched_barrier(0);
        GAS u32x2* o8 = (GAS u32x2*)(F.XN + (size_t)m * DM) + F.lane; GAS u32x2* o82 = (GAS u32x2*)(F.XN + (size_t)m2 * DM) + F.lane;
#pragma unroll
        for (int j = 0; j < 4; ++j) { const f32x4 o = v[j] * rinv * a[j] + sh[j]; u32x2 w; w.x = cvtpk(o.x, o.y); w.y = cvtpk(o.z, o.w); o8[64 * j] = w;
            const f32x4 o2 = u[j] * rinv2 * a[j] + sh[j]; u32x2 w2; w2.x = cvtpk(o2.x, o2.y); w2.y = cvtpk(o2.z, o2.w); o82[64 * j] = w2; }
#pragma unroll
        for (int j = 0; j < 4; ++j) { v[j] = vn[j]; u[j] = un[j]; }
    }
    __syncthreads();
}
struct Epi1 {
    static constexpr bool PERM = false, AFTER_DRAIN = false;
    bf16 *DQ, *DK, *DV, *SG, *CQ, *CKV, *KR; const float *gq, *gk;
    __device__ __forceinline__ void operator()(const f32x4 (&acc)[2][2][4][2], const pg8::Unit& u, int wr, int wc, int fr, int fq) const {
        const int G = u.pn * 4 + wc, rowb = u.pm * 256 + wr * 64 + fr, c8 = 8 * fq;
        if (G < 16) {
            const bool isq = G < 8; const int g8 = G & 7, h = g8 >> 1, c = g8 & 1; const float* gain = isq ? gq : gk;
            bf16* dst = (isq ? DQ : DK) + (size_t)h * S * 128 + 64 * c + c8; const float mul = isq ? DIFF_C : 1.f;
            f32x4 gv[2][2];
#pragma unroll
            for (int bj = 0; bj < 2; ++bj)
#pragma unroll
                for (int n = 0; n < 2; ++n) gv[bj][n] = *(const GAS f32x4*)(gain + 32 * bj + c8 + 4 * n);
#pragma unroll
            for (int ai = 0; ai < 2; ++ai)
#pragma unroll
                for (int m = 0; m < 4; ++m) {
                    float s = 0.f;
#pragma unroll
                    for (int bj = 0; bj < 2; ++bj)
#pragma unroll
                        for (int n = 0; n < 2; ++n) { const f32x4 v = acc[ai][bj][m][n]; s += (v.x * v.x + v.y * v.y) + (v.z * v.z + v.w * v.w); }
                    s += __shfl_xor(s, 16); s += __shfl_xor(s, 32);
                    const float rinv = rsqrtf(s * (1.f / 64.f) + RMS_EPS) * mul;
                    bf16* rp = dst + (size_t)(rowb + 128 * ai + 16 * m) * 128;
#pragma unroll
                    for (int bj = 0; bj < 2; ++bj) { const f32x4 v0 = acc[ai][bj][m][0] * rinv * gv[bj][0], v1 = acc[ai][bj][m][1] * rinv * gv[bj][1];
                        v4u w; w.x = cvtpk(v0.x, v0.y); w.y = cvtpk(v0.z, v0.w); w.z = cvtpk(v1.x, v1.y); w.w = cvtpk(v1.z, v1.w); *(GAS v4u*)(rp + 32 * bj) = w; }
                }
        } else if (G < 24 || (G >= 31 && G < 47)) {
            const bool isv = G < 24; bf16* dst; int ld;
            if (isv) { const int h = (G - 16) >> 1, half = (G - 16) & 1; dst = DV + (size_t)h * S * 128 + 64 * half + c8; ld = 128; }
            else { dst = SG + 64 * (G - 31) + c8; ld = 1024; }
#pragma unroll
            for (int ai = 0; ai < 2; ++ai)
#pragma unroll
                for (int m = 0; m < 4; ++m) { bf16* rp = dst + (size_t)(rowb + 128 * ai + 16 * m) * ld;
#pragma unroll
                    for (int bj = 0; bj < 2; ++bj) { f32x4 v0 = acc[ai][bj][m][0], v1 = acc[ai][bj][m][1];
                        if (!isv) { v0.x = silu_g(v0.x); v0.y = silu_g(v0.y); v0.z = silu_g(v0.z); v0.w = silu_g(v0.w); v1.x = silu_g(v1.x); v1.y = silu_g(v1.y); v1.z = silu_g(v1.z); v1.w = silu_g(v1.w); }
                        v4u w; w.x = cvtpk(v0.x, v0.y); w.y = cvtpk(v0.z, v0.w); w.z = cvtpk(v1.x, v1.y); w.w = cvtpk(v1.z, v1.w); *(GAS v4u*)(rp + 32 * bj) = w; } }
        } else if (G < 31) {
            bf16* dst; int ld;
            if (G < 28) { dst = CQ + 64 * (G - 24) + c8; ld = 256; } else if (G < 30) { dst = CKV + 64 * (G - 28) + c8; ld = 128; } else { dst = KR + c8; ld = 64; }
#pragma unroll
            for (int ai = 0; ai < 2; ++ai)
#pragma unroll
                for (int m = 0; m < 4; ++m) { bf16* rp = dst + (size_t)(rowb + 128 * ai + 16 * m) * ld;
#pragma unroll
                    for (int bj = 0; bj < 2; ++bj) { const f32x4 v0 = acc[ai][bj][m][0], v1 = acc[ai][bj][m][1];
                        v4u w; w.x = cvtpk(v0.x, v0.y); w.y = cvtpk(v0.z, v0.w); w.z = cvtpk(v1.x, v1.y); w.w = cvtpk(v1.z, v1.w); *(GAS v4u*)(rp + 32 * bj) = w; } }
        }
    }
};
#ifndef TS_DET
#define TS_DET 0
#endif
struct Epi3 {
    static constexpr bool PERM = false, AFTER_DRAIN = false;
    const float* x; float* out; const float* gate;
    __device__ __forceinline__ void operator()(const f32x4 (&acc)[2][2][4][2], const pg8::Unit& u, int wr, int wc, int fr, int fq) const {
        const int rowb = u.pm * 256 + wr * 64 + fr, col0 = u.pn * 256 + 64 * wc + 4 * fq;
        f32x4 gv[2][2];
#pragma unroll
        for (int bj = 0; bj < 2; ++bj)
#pragma unroll
            for (int n = 0; n < 2; ++n) gv[bj][n] = *(const GAS f32x4*)(gate + col0 + 32 * bj + 16 * n);
#pragma unroll
        for (int ai = 0; ai < 2; ++ai) {
            f32x4 xv[4][2][2];
#pragma unroll
            for (int m = 0; m < 4; ++m) { const size_t off = (size_t)(rowb + 128 * ai + 16 * m) * DM + col0;
#pragma unroll
                for (int bj = 0; bj < 2; ++bj)
#pragma unroll
                    for (int n = 0; n < 2; ++n) xv[m][bj][n] = *(const GAS f32x4*)(x + off + 32 * bj + 16 * n); }
            __builtin_amdgcn_sched_barrier(0);
#pragma unroll
            for (int m = 0; m < 4; ++m) { const size_t off = (size_t)(rowb + 128 * ai + 16 * m) * DM + col0;
#pragma unroll
                for (int bj = 0; bj < 2; ++bj)
#pragma unroll
                    for (int n = 0; n < 2; ++n) *(GAS f32x4*)(out + off + 32 * bj + 16 * n) = TS_DET ? xv[m][bj][n] : (xv[m][bj][n] + gv[bj][n] * acc[ai][bj][m][n]); }
            __builtin_amdgcn_sched_barrier(0);
        }
    }
};
template <int KB> __device__ __forceinline__ void stage_w_dma(const bf16* src, LAS unsigned char* dst, int nrows, int wave, int lane) {
    constexpr int CPR = KB / 16; const int npieces = nrows * CPR / 64;
    for (int pc = wave; pc < npieces; pc += NWAVES) { const int p = pc * 64 + lane, row = p / CPR, ch = (p % CPR) ^ (row & 15);
        __builtin_amdgcn_global_load_lds((const GAS unsigned*)((const char*)src + (size_t)row * KB + ch * 16), (LAS unsigned*)(dst + pc * 1024), 16, 0, 0); }
}
template <int KSTEPS, int KB> __device__ __forceinline__ void rowown_mma(f32x16& acc, const char* wl, int cb, const bf16x8* xf, int r32, int hi) {
    const char* rp = wl + (32 * cb + r32) * KB;
#pragma unroll
    for (int s = 0; s < KSTEPS; ++s) { const bf16x8 a = *(const bf16x8*)(rp + (((2 * s + hi) ^ (r32 & 15)) << 4)); acc = __builtin_amdgcn_mfma_f32_32x32x16_bf16(a, xf[s], acc, 0, 0, 0); }
}
__device__ __forceinline__ void store_chunk64(const f32x16& a0, const f32x16& a1, char* stg, bf16* dst_row0, int ld, int r32, int hi, int lane) {
#pragma unroll
    for (int g = 0; g < 4; ++g) { u32x2 w0, w1; w0.x = cvtpk(a0[4 * g], a0[4 * g + 1]); w0.y = cvtpk(a0[4 * g + 2], a0[4 * g + 3]); w1.x = cvtpk(a1[4 * g], a1[4 * g + 1]); w1.y = cvtpk(a1[4 * g + 2], a1[4 * g + 3]);
        *(u32x2*)(stg + r32 * 128 + (8 * g + 4 * hi) * 2) = w0; *(u32x2*)(stg + r32 * 128 + (32 + 8 * g + 4 * hi) * 2) = w1; }
    asm volatile("s_waitcnt lgkmcnt(0)" ::: "memory");
    v4u vs[4];
#pragma unroll
    for (int i = 0; i < 4; ++i) { const int row = 8 * i + (lane >> 3), ch = lane & 7; vs[i] = *(const LAS v4u*)(unsigned)(uintptr_t)(stg + row * 128 + ch * 16); }
    asm volatile("s_waitcnt lgkmcnt(0)" ::: "memory");
#pragma unroll
    for (int i = 0; i < 4; ++i) { const int row = 8 * i + (lane >> 3), ch = lane & 7; *(GAS v4u*)(dst_row0 + (size_t)row * ld + 8 * ch) = vs[i]; }
    asm volatile("s_waitcnt lgkmcnt(0)" ::: "memory");
}
#ifndef TS_SEL
#define TS_SEL 0
#endif
#define P1B_STAMP(F, k) do { if (TS_SEL == 10 && F.wave == 0 && __builtin_amdgcn_mbcnt_hi(~0u, __builtin_amdgcn_mbcnt_lo(~0u, 0u)) == 0u) { ((volatile LAS unsigned long long*)(F.lds + MISC_OFF + 64))[k] = __builtin_amdgcn_s_memrealtime(); } } while (0)
template <int NCB, int KSTEPS, int KB> __device__ __forceinline__ void rowown_mma_all(f32x16 (&acc)[NCB], const char* wl, const bf16x8* xf, int r32, int hi) {
    const char* rp = wl + r32 * KB; const int xr = r32 & 15;
    bf16x8 fa[NCB], fb[NCB];
#pragma unroll
    for (int cb = 0; cb < NCB; ++cb) { acc[cb] = f32x16{}; fa[cb] = *(const bf16x8*)(rp + cb * 32 * KB + (((0 + hi) ^ xr) << 4)); }
#pragma unroll
    for (int s = 0; s < KSTEPS; s += 2) {
#pragma unroll
        for (int cb = 0; cb < NCB; ++cb) fb[cb] = *(const bf16x8*)(rp + cb * 32 * KB + (((2 * (s + 1) + hi) ^ xr) << 4));
        __builtin_amdgcn_sched_barrier(0);
#pragma unroll
        for (int cb = 0; cb < NCB; ++cb) acc[cb] = __builtin_amdgcn_mfma_f32_32x32x16_bf16(fa[cb], xf[s], acc[cb], 0, 0, 0);
        __builtin_amdgcn_sched_barrier(0);
        if (s + 2 < KSTEPS) {
#pragma unroll
            for (int cb = 0; cb < NCB; ++cb) fa[cb] = *(const bf16x8*)(rp + cb * 32 * KB + (((2 * (s + 2) + hi) ^ xr) << 4));
        }
        __builtin_amdgcn_sched_barrier(0);
#pragma unroll
        for (int cb = 0; cb < NCB; ++cb) acc[cb] = __builtin_amdgcn_mfma_f32_32x32x16_bf16(fb[cb], xf[s + 1], acc[cb], 0, 0, 0);
        __builtin_amdgcn_sched_barrier(0);
    }
}
template <bool PREFETCHED> __device__ __forceinline__ void p1b_q_unit(Frame& F, int rb, int h, char* lds) {
    int lane_o = (int)__builtin_amdgcn_mbcnt_hi(~0u, __builtin_amdgcn_mbcnt_lo(~0u, 0u)); asm volatile("" : "+v"(lane_o));
    const int lane = lane_o, r32 = lane & 31, hi = lane >> 5, row = 256 * rb + 32 * F.wave + r32;
    P1B_STAMP(F, 0);
    if (!PREFETCHED) { __syncthreads(); stage_w_dma<512>(F.WUQT + (size_t)192 * h * 256, F.lds, 192, F.wave, lane); }
    bf16x8 xf[16]; float ssq = 0.f;
    { const bf16* xr = F.CQ + (size_t)row * 256 + 8 * hi;
      v4u xw_[16];
#pragma unroll
      for (int s = 0; s < 16; ++s) xw_[s] = *(const GAS v4u*)(xr + 16 * s);
#pragma unroll
      for (int hb = 0; hb < 2; ++hb) { f32x4 gq_[8][2];
#pragma unroll
          for (int s = 0; s < 8; ++s) { gq_[s][0] = *(const GAS f32x4*)(F.qan + 16 * (8 * hb + s) + 8 * hi); gq_[s][1] = *(const GAS f32x4*)(F.qan + 16 * (8 * hb + s) + 8 * hi + 4); }
          __builtin_amdgcn_sched_barrier(0);
#pragma unroll
          for (int s8 = 0; s8 < 8; ++s8) { const int s = 8 * hb + s8; const v4u xw = xw_[s];
              const f32x4 x0 = {__uint_as_float(xw.x << 16), __uint_as_float(xw.x & 0xffff0000u), __uint_as_float(xw.y << 16), __uint_as_float(xw.y & 0xffff0000u)};
              const f32x4 x1 = {__uint_as_float(xw.z << 16), __uint_as_float(xw.z & 0xffff0000u), __uint_as_float(xw.w << 16), __uint_as_float(xw.w & 0xffff0000u)};
              const f32x4 g0 = gq_[s8][0], g1 = gq_[s8][1];
              ssq += (x0.x * x0.x + x0.y * x0.y) + (x0.z * x0.z + x0.w * x0.w) + (x1.x * x1.x + x1.y * x1.y) + (x1.z * x1.z + x1.w * x1.w);
              const f32x4 y0 = x0 * g0, y1 = x1 * g1; v4u w; w.x = cvtpk(y0.x, y0.y); w.y = cvtpk(y0.z, y0.w); w.z = cvtpk(y1.x, y1.y); w.w = cvtpk(y1.z, y1.w); xf[s] = __builtin_bit_cast(bf16x8, w); }
          __builtin_amdgcn_sched_barrier(0); } }
    const float rinv_a = rsqrtf(half_swap_add(ssq) * (1.f / 256.f) + RMS_EPS);
    P1B_STAMP(F, 1);
    __syncthreads();
    P1B_STAMP(F, 2);
    f32x16 acc[6]; rowown_mma_all<6, 16, 512>(acc, lds, xf, r32, hi);
    asm volatile("" : "+v"(acc[0]), "+v"(acc[5])); P1B_STAMP(F, 3);
    __syncthreads();
    stage_w_dma<256>(F.WUKT + (size_t)128 * h * 128, F.lds, 128, F.wave, lane);
    stage_w_dma<256>(F.WUVT + (size_t)128 * h * 128, F.lds + 32768, 128, F.wave, lane);
    float s2 = 0.f;
#pragma unroll
    for (int g = 0; g < 4; ++g) { const f32x4 c4 = *(const GAS f32x4*)(F.ROPE + (size_t)row * 64 + 8 * g + 4 * hi), s4 = *(const GAS f32x4*)(F.ROPE + (size_t)row * 64 + 32 + 8 * g + 4 * hi);
#pragma unroll
        for (int e = 0; e < 4; ++e) { const int r = 4 * g + e; const float cs = c4[e], sn = s4[e];
            const float x1 = acc[4][r] * rinv_a, x2 = acc[5][r] * rinv_a; acc[4][r] = x1 * cs - x2 * sn; acc[5][r] = x2 * cs + x1 * sn; } }
#pragma unroll
    for (int cb = 0; cb < 4; ++cb)
#pragma unroll
        for (int r = 0; r < 16; ++r) acc[cb][r] *= rinv_a;
#pragma unroll
    for (int cb = 0; cb < 6; ++cb)
#pragma unroll
        for (int r = 0; r < 16; ++r) s2 += acc[cb][r] * acc[cb][r];
    const float rinv2 = rsqrtf(half_swap_add(s2) * (1.f / 192.f) + RMS_EPS) * MLA_C;
#pragma unroll
    for (int cb = 0; cb < 6; ++cb)
#pragma unroll
        for (int g = 0; g < 4; ++g) { const f32x4 gn = *(const GAS f32x4*)(F.mqn + 32 * cb + 8 * g + 4 * hi);
            acc[cb][4 * g] *= rinv2 * gn.x; acc[cb][4 * g + 1] *= rinv2 * gn.y; acc[cb][4 * g + 2] *= rinv2 * gn.z; acc[cb][4 * g + 3] *= rinv2 * gn.w; }
    { char* stg = lds + 98304 + F.wave * 4096; bf16* q0 = F.QM + ((size_t)h * S + 256 * rb + 32 * F.wave) * 192;
      P1B_STAMP(F, 4); store_chunk64(acc[0], acc[1], stg, q0, 192, r32, hi, lane); store_chunk64(acc[2], acc[3], stg, q0 + 64, 192, r32, hi, lane); store_chunk64(acc[4], acc[5], stg, q0 + 128, 192, r32, hi, lane); }
    P1B_STAMP(F, 5);
}
__device__ __forceinline__ void p1b_kv_unit(Frame& F, int rb, int h, char* lds) {
    int lane_o = (int)__builtin_amdgcn_mbcnt_hi(~0u, __builtin_amdgcn_mbcnt_lo(~0u, 0u)); asm volatile("" : "+v"(lane_o));
    const int lane = lane_o, r32 = lane & 31, hi = lane >> 5, row = 256 * rb + 32 * F.wave + r32;
    bf16x8 xf[8]; float ssq = 0.f;
    { const bf16* xr = F.CKV + (size_t)row * 128 + 8 * hi;
      v4u xw_[8]; f32x4 gk_[8][2];
#pragma unroll
      for (int s = 0; s < 8; ++s) { xw_[s] = *(const GAS v4u*)(xr + 16 * s); gk_[s][0] = *(const GAS f32x4*)(F.kvan + 16 * s + 8 * hi); gk_[s][1] = *(const GAS f32x4*)(F.kvan + 16 * s + 8 * hi + 4); }
      __builtin_amdgcn_sched_barrier(0);
#pragma unroll
      for (int s = 0; s < 8; ++s) { const v4u xw = xw_[s];
          const f32x4 x0 = {__uint_as_float(xw.x << 16), __uint_as_float(xw.x & 0xffff0000u), __uint_as_float(xw.y << 16), __uint_as_float(xw.y & 0xffff0000u)};
          const f32x4 x1 = {__uint_as_float(xw.z << 16), __uint_as_float(xw.z & 0xffff0000u), __uint_as_float(xw.w << 16), __uint_as_float(xw.w & 0xffff0000u)};
          const f32x4 g0 = gk_[s][0], g1 = gk_[s][1];
          ssq += (x0.x * x0.x + x0.y * x0.y) + (x0.z * x0.z + x0.w * x0.w) + (x1.x * x1.x + x1.y * x1.y) + (x1.z * x1.z + x1.w * x1.w);
          const f32x4 y0 = x0 * g0, y1 = x1 * g1; v4u w; w.x = cvtpk(y0.x, y0.y); w.y = cvtpk(y0.z, y0.w); w.z = cvtpk(y1.x, y1.y); w.w = cvtpk(y1.z, y1.w); xf[s] = __builtin_bit_cast(bf16x8, w); } }
    const float rinv_a = rsqrtf(half_swap_add(ssq) * (1.f / 128.f) + RMS_EPS);
    P1B_STAMP(F, 6);
    __syncthreads();
    P1B_STAMP(F, 7);
    { f32x16 av[4]; rowown_mma_all<4, 8, 256>(av, lds + 32768, xf, r32, hi);
#pragma unroll
      for (int cb = 0; cb < 4; ++cb)
#pragma unroll
          for (int r = 0; r < 16; ++r) av[cb][r] *= rinv_a;
      char* stg = lds + 98304 + F.wave * 4096; bf16* v0 = F.VM + ((size_t)h * S + 256 * rb + 32 * F.wave) * 128;
      store_chunk64(av[0], av[1], stg, v0, 128, r32, hi, lane); store_chunk64(av[2], av[3], stg, v0 + 64, 128, r32, hi, lane); }
    P1B_STAMP(F, 8);
    f32x16 ak[4]; rowown_mma_all<4, 8, 256>(ak, lds, xf, r32, hi);
    float pe1[16], pe2[16]; float s2 = 0.f;
    { const bf16* kr = F.KR + (size_t)row * 64 + 4 * hi;
#pragma unroll
      for (int g = 0; g < 4; ++g) { const u32x2 a = *(const GAS u32x2*)(kr + 8 * g), b = *(const GAS u32x2*)(kr + 32 + 8 * g);
          pe1[4 * g] = __uint_as_float(a.x << 16); pe1[4 * g + 1] = __uint_as_float(a.x & 0xffff0000u); pe1[4 * g + 2] = __uint_as_float(a.y << 16); pe1[4 * g + 3] = __uint_as_float(a.y & 0xffff0000u);
          pe2[4 * g] = __uint_as_float(b.x << 16); pe2[4 * g + 1] = __uint_as_float(b.x & 0xffff0000u); pe2[4 * g + 2] = __uint_as_float(b.y << 16); pe2[4 * g + 3] = __uint_as_float(b.y & 0xffff0000u); } }
#pragma unroll
    for (int g = 0; g < 4; ++g) { const f32x4 c4 = *(const GAS f32x4*)(F.ROPE + (size_t)row * 64 + 8 * g + 4 * hi), s4 = *(const GAS f32x4*)(F.ROPE + (size_t)row * 64 + 32 + 8 * g + 4 * hi);
#pragma unroll
        for (int e = 0; e < 4; ++e) { const int r = 4 * g + e; const float cs = c4[e], sn = s4[e]; const float x1 = pe1[r], x2 = pe2[r]; pe1[r] = x1 * cs - x2 * sn; pe2[r] = x2 * cs + x1 * sn; s2 += pe1[r] * pe1[r] + pe2[r] * pe2[r]; } }
#pragma unroll
    for (int cb = 0; cb < 4; ++cb)
#pragma unroll
        for (int r = 0; r < 16; ++r) { ak[cb][r] *= rinv_a; s2 += ak[cb][r] * ak[cb][r]; }
    const float rinv2 = rsqrtf(half_swap_add(s2) * (1.f / 192.f) + RMS_EPS);
#pragma unroll
    for (int cb = 0; cb < 4; ++cb)
#pragma unroll
        for (int g = 0; g < 4; ++g) { const f32x4 gn = *(const GAS f32x4*)(F.mkn + 32 * cb + 8 * g + 4 * hi);
            ak[cb][4 * g] *= rinv2 * gn.x; ak[cb][4 * g + 1] *= rinv2 * gn.y; ak[cb][4 * g + 2] *= rinv2 * gn.z; ak[cb][4 * g + 3] *= rinv2 * gn.w; }
    f32x16 p1v, p2v;
#pragma unroll
    for (int g = 0; g < 4; ++g) { const f32x4 g1 = *(const GAS f32x4*)(F.mkn + 128 + 8 * g + 4 * hi), g2 = *(const GAS f32x4*)(F.mkn + 160 + 8 * g + 4 * hi);
        p1v[4 * g] = pe1[4 * g] * rinv2 * g1.x; p1v[4 * g + 1] = pe1[4 * g + 1] * rinv2 * g1.y; p1v[4 * g + 2] = pe1[4 * g + 2] * rinv2 * g1.z; p1v[4 * g + 3] = pe1[4 * g + 3] * rinv2 * g1.w;
        p2v[4 * g] = pe2[4 * g] * rinv2 * g2.x; p2v[4 * g + 1] = pe2[4 * g + 1] * rinv2 * g2.y; p2v[4 * g + 2] = pe2[4 * g + 2] * rinv2 * g2.z; p2v[4 * g + 3] = pe2[4 * g + 3] * rinv2 * g2.w; }
    { char* stg = lds + 98304 + F.wave * 4096; bf16* k0 = F.KM + ((size_t)h * S + 256 * rb + 32 * F.wave) * 192;
      store_chunk64(ak[0], ak[1], stg, k0, 192, r32, hi, lane); store_chunk64(ak[2], ak[3], stg, k0 + 64, 192, r32, hi, lane); store_chunk64(p1v, p2v, stg, k0 + 128, 192, r32, hi, lane); }
    P1B_STAMP(F, 9);
}
__device__ __forceinline__ int p1b_unit_of(int b) { const int x = b & 7, j = b >> 3; return ((8 * x + (j >> 2)) << 2) | (j & 3); }
__device__ __forceinline__ void p1b_prefetch(Frame& F) {
    const int u = (blockIdx.x < 256 && F.G == 256) ? p1b_unit_of(blockIdx.x) : (int)blockIdx.x; if (blockIdx.x < 256) stage_w_dma<512>(F.WUQT + (size_t)192 * (u & 3) * 256, F.lds, 192, F.wave, (int)__builtin_amdgcn_mbcnt_hi(~0u, __builtin_amdgcn_mbcnt_lo(~0u, 0u)));
}
__device__ __forceinline__ void p1b_phase(Frame& F) {
    char* lds = (char*)F.lds;
    bool first = true;
#ifndef P1B_ABL
#define P1B_ABL 0
#endif
    for (int u0 = blockIdx.x; u0 < 256; u0 += F.G) { const int u = (F.G == 256) ? p1b_unit_of(u0) : u0; if (!(P1B_ABL & 1)) { if (first) p1b_q_unit<true>(F, u >> 2, u & 3, lds); else p1b_q_unit<false>(F, u >> 2, u & 3, lds); } first = false; if (!(P1B_ABL & 2)) p1b_kv_unit(F, u >> 2, u & 3, lds); }
    __syncthreads();
}
}
namespace mk {
constexpr int AL_V = 0, AL_K = 49152, AL_WS = 49152 + 73728, AL_TBL = AL_WS + 2048, AL_BC = AL_TBL + 1024, AL_X = 0, AL_STG = 65536, AL_TICKET = 131072;
#define SBAR() __builtin_amdgcn_sched_barrier(0)
#ifndef QK_SB
#define QK_SB 4
#endif
__device__ __forceinline__ int v_st(int k, int c) { return ((k >> 3) * 4 + (c >> 5)) * 512 + ((k & 7) * 32 + (c & 31)) * 2; }
__device__ __forceinline__ int v_rd_base(int lane) { return ((lane & 3) << 3) | (((lane >> 2) & 3) << 6) | (((lane >> 4) & 1) << 5) | (((lane >> 5) & 1) << 8); }
constexpr int v_rd_off(int d0, int ks, int half) { return d0 * 512 + ks * 4096 + half * 2048; }
typedef short v4i16_t __attribute__((ext_vector_type(4)));
template <int OFF> __device__ __forceinline__ s16x4 tr_read(int vb) {
    return __builtin_bit_cast(s16x4, __builtin_amdgcn_ds_read_tr16_b64_v4i16((LAS v4i16_t*)(unsigned)(vb + OFF))); }
template <int D0> __device__ __forceinline__ void pv_one(f32x16& od, int vb, bf16x8 pa0, bf16x8 pa1, bf16x8 pa2, bf16x8 pa3) {
    const s16x4 l0 = tr_read<v_rd_off(D0, 0, 0)>(vb), h0 = tr_read<v_rd_off(D0, 0, 1)>(vb), l1 = tr_read<v_rd_off(D0, 1, 0)>(vb), h1 = tr_read<v_rd_off(D0, 1, 1)>(vb);
    const s16x4 l2 = tr_read<v_rd_off(D0, 2, 0)>(vb), h2 = tr_read<v_rd_off(D0, 2, 1)>(vb), l3 = tr_read<v_rd_off(D0, 3, 0)>(vb), h3 = tr_read<v_rd_off(D0, 3, 1)>(vb);
    asm volatile("s_waitcnt lgkmcnt(0)" ::: "memory"); SBAR();
#define PK(L, H) (bf16x8){L[0], L[1], L[2], L[3], H[0], H[1], H[2], H[3]}
    od = __builtin_amdgcn_mfma_f32_32x32x16_bf16(pa0, PK(l0, h0), od, 0, 0, 0);
    od = __builtin_amdgcn_mfma_f32_32x32x16_bf16(pa1, PK(l1, h1), od, 0, 0, 0);
    od = __builtin_amdgcn_mfma_f32_32x32x16_bf16(pa2, PK(l2, h2), od, 0, 0, 0);
    od = __builtin_amdgcn_mfma_f32_32x32x16_bf16(pa3, PK(l3, h3), od, 0, 0, 0);
#undef PK
}
__device__ __forceinline__ void pv_all(f32x16* o, int vb, bf16x8 pa0, bf16x8 pa1, bf16x8 pa2, bf16x8 pa3) {
    pv_one<0>(o[0], vb, pa0, pa1, pa2, pa3); pv_one<1>(o[1], vb, pa0, pa1, pa2, pa3); pv_one<2>(o[2], vb, pa0, pa1, pa2, pa3); pv_one<3>(o[3], vb, pa0, pa1, pa2, pa3);
}
__device__ __forceinline__ bf16x8 pack8(const f32x16& p, int b) {
    v4u w; w.x = cvtpk(p[b], p[b + 1]); w.y = cvtpk(p[b + 2], p[b + 3]); w.z = cvtpk(p[b + 4], p[b + 5]); w.w = cvtpk(p[b + 6], p[b + 7]); return __builtin_bit_cast(bf16x8, w);
}
template <int HF> __device__ __forceinline__ void vread_all(int vb, s16x4 (&vl)[8], s16x4 (&vh)[8]) {
    vl[0] = tr_read<v_rd_off(0, 2 * HF, 0)>(vb); vh[0] = tr_read<v_rd_off(0, 2 * HF, 1)>(vb); vl[1] = tr_read<v_rd_off(0, 2 * HF + 1, 0)>(vb); vh[1] = tr_read<v_rd_off(0, 2 * HF + 1, 1)>(vb);
    vl[2] = tr_read<v_rd_off(1, 2 * HF, 0)>(vb); vh[2] = tr_read<v_rd_off(1, 2 * HF, 1)>(vb); vl[3] = tr_read<v_rd_off(1, 2 * HF + 1, 0)>(vb); vh[3] = tr_read<v_rd_off(1, 2 * HF + 1, 1)>(vb);
    vl[4] = tr_read<v_rd_off(2, 2 * HF, 0)>(vb); vh[4] = tr_read<v_rd_off(2, 2 * HF, 1)>(vb); vl[5] = tr_read<v_rd_off(2, 2 * HF + 1, 0)>(vb); vh[5] = tr_read<v_rd_off(2, 2 * HF + 1, 1)>(vb);
    vl[6] = tr_read<v_rd_off(3, 2 * HF, 0)>(vb); vh[6] = tr_read<v_rd_off(3, 2 * HF, 1)>(vb); vl[7] = tr_read<v_rd_off(3, 2 * HF + 1, 0)>(vb); vh[7] = tr_read<v_rd_off(3, 2 * HF + 1, 1)>(vb);
}
__device__ __forceinline__ void pv_mma(f32x16* o, bf16x8 pa0, bf16x8 pa1, const s16x4 (&vl)[8], const s16x4 (&vh)[8]) {
    asm volatile("s_waitcnt lgkmcnt(0)" ::: "memory"); SBAR();
#define PK(L, H) (bf16x8){L[0], L[1], L[2], L[3], H[0], H[1], H[2], H[3]}
    o[0] = __builtin_amdgcn_mfma_f32_32x32x16_bf16(pa0, PK(vl[0], vh[0]), o[0], 0, 0, 0);
    o[1] = __builtin_amdgcn_mfma_f32_32x32x16_bf16(pa0, PK(vl[2], vh[2]), o[1], 0, 0, 0);
    o[2] = __builtin_amdgcn_mfma_f32_32x32x16_bf16(pa0, PK(vl[4], vh[4]), o[2], 0, 0, 0);
    o[3] = __builtin_amdgcn_mfma_f32_32x32x16_bf16(pa0, PK(vl[6], vh[6]), o[3], 0, 0, 0);
    o[0] = __builtin_amdgcn_mfma_f32_32x32x16_bf16(pa1, PK(vl[1], vh[1]), o[0], 0, 0, 0);
    o[1] = __builtin_amdgcn_mfma_f32_32x32x16_bf16(pa1, PK(vl[3], vh[3]), o[1], 0, 0, 0);
    o[2] = __builtin_amdgcn_mfma_f32_32x32x16_bf16(pa1, PK(vl[5], vh[5]), o[2], 0, 0, 0);
    o[3] = __builtin_amdgcn_mfma_f32_32x32x16_bf16(pa1, PK(vl[7], vh[7]), o[3], 0, 0, 0);
#undef PK
}
template <int HF> __device__ __forceinline__ void vread_lo(int vb, s16x4 (&vl)[8], s16x4 (&vh)[8]) {
    vl[0] = tr_read<v_rd_off(0, 2 * HF, 0)>(vb); vh[0] = tr_read<v_rd_off(0, 2 * HF, 1)>(vb); vl[1] = tr_read<v_rd_off(0, 2 * HF + 1, 0)>(vb); vh[1] = tr_read<v_rd_off(0, 2 * HF + 1, 1)>(vb);
    vl[2] = tr_read<v_rd_off(1, 2 * HF, 0)>(vb); vh[2] = tr_read<v_rd_off(1, 2 * HF, 1)>(vb); vl[3] = tr_read<v_rd_off(1, 2 * HF + 1, 0)>(vb); vh[3] = tr_read<v_rd_off(1, 2 * HF + 1, 1)>(vb);
}
template <int HF> __device__ __forceinline__ void pv_mma_split(f32x16* o, int vb, bf16x8 pa0, bf16x8 pa1, s16x4 (&vl)[8], s16x4 (&vh)[8]) {
    asm volatile("s_waitcnt lgkmcnt(0)" ::: "memory"); SBAR();
    vl[4] = tr_read<v_rd_off(2, 2 * HF, 0)>(vb); vh[4] = tr_read<v_rd_off(2, 2 * HF, 1)>(vb); vl[5] = tr_read<v_rd_off(2, 2 * HF + 1, 0)>(vb); vh[5] = tr_read<v_rd_off(2, 2 * HF + 1, 1)>(vb);
    vl[6] = tr_read<v_rd_off(3, 2 * HF, 0)>(vb); vh[6] = tr_read<v_rd_off(3, 2 * HF, 1)>(vb); vl[7] = tr_read<v_rd_off(3, 2 * HF + 1, 0)>(vb); vh[7] = tr_read<v_rd_off(3, 2 * HF + 1, 1)>(vb);
#define PK(L, H) (bf16x8){L[0], L[1], L[2], L[3], H[0], H[1], H[2], H[3]}
    o[0] = __builtin_amdgcn_mfma_f32_32x32x16_bf16(pa0, PK(vl[0], vh[0]), o[0], 0, 0, 0);
    o[1] = __builtin_amdgcn_mfma_f32_32x32x16_bf16(pa0, PK(vl[2], vh[2]), o[1], 0, 0, 0);
    o[0] = __builtin_amdgcn_mfma_f32_32x32x16_bf16(pa1, PK(vl[1], vh[1]), o[0], 0, 0, 0);
    o[1] = __builtin_amdgcn_mfma_f32_32x32x16_bf16(pa1, PK(vl[3], vh[3]), o[1], 0, 0, 0);
    asm volatile("s_waitcnt lgkmcnt(0)" ::: "memory"); SBAR();
    o[2] = __builtin_amdgcn_mfma_f32_32x32x16_bf16(pa0, PK(vl[4], vh[4]), o[2], 0, 0, 0);
    o[3] = __builtin_amdgcn_mfma_f32_32x32x16_bf16(pa0, PK(vl[6], vh[6]), o[3], 0, 0, 0);
    o[2] = __builtin_amdgcn_mfma_f32_32x32x16_bf16(pa1, PK(vl[5], vh[5]), o[2], 0, 0, 0);
    o[3] = __builtin_amdgcn_mfma_f32_32x32x16_bf16(pa1, PK(vl[7], vh[7]), o[3], 0, 0, 0);
#undef PK
}
__device__ __forceinline__ unsigned cvtpk_s(float lo, float hi) { typedef float f2_t __attribute__((ext_vector_type(2))); typedef __bf16 b2_t __attribute__((ext_vector_type(2)));
    f2_t v = {lo, hi}; b2_t b = __builtin_convertvector(v, b2_t); return __builtin_bit_cast(unsigned, b); }
__device__ __forceinline__ void glds16(const void* gsrc, unsigned lds_dst) { unsigned keep;
    asm volatile("s_mov_b32 %0, m0\n\ts_mov_b32 m0, %2\n\ts_nop 0\n\tglobal_load_lds_dwordx4 %1, off\n\ts_mov_b32 m0, %0" : "=&s"(keep) : "v"(gsrc), "s"(lds_dst) : "memory"); }
__device__ __forceinline__ float fadd_s(float a, float b) { float r; asm("v_add_f32_e32 %0, %1, %2" : "=v"(r) : "v"(a), "v"(b)); return r; }
template <int B> __device__ __forceinline__ void mma16(f32x16& c, bf16x8 a, bf16x8 b) {
    f32x4 t = {c[B], c[B + 1], c[B + 2], c[B + 3]}; t = __builtin_amdgcn_mfma_f32_16x16x32_bf16(a, b, t, 0, 0, 0); c[B] = t[0]; c[B + 1] = t[1]; c[B + 2] = t[2]; c[B + 3] = t[3]; }
template <int B> __device__ __forceinline__ void mma16z(f32x16& c, bf16x8 a, bf16x8 b) {
    f32x4 t = {0.f, 0.f, 0.f, 0.f}; t = __builtin_amdgcn_mfma_f32_16x16x32_bf16(a, b, t, 0, 0, 0); c[B] = t[0]; c[B + 1] = t[1]; c[B + 2] = t[2]; c[B + 3] = t[3]; }
constexpr int v_off16(int dt, int hf, int blk) { return hf * 8192 + blk * 4096 + (dt >> 1) * 512; }
template <bool DIFF>
__device__ __forceinline__ void attn_unit(Frame& F, int h, int qb, char* lds) {
    constexpr int KS2 = DIFF ? 2 : 6, KROWB = DIFF ? 256 : 384, KTILE = 64 * KROWB, NKC = KTILE / (512 * 16), KBUF = 24576, VBUF = 16384, QLD = DIFF ? 128 : 192;
    int tid_o = F.wave * 64 + (int)__builtin_amdgcn_mbcnt_hi(~0u, __builtin_amdgcn_mbcnt_lo(~0u, 0u)); asm volatile("" : "+v"(tid_o));
    const int tid = tid_o, wid = F.wave, lane = tid & 63, l16 = lane & 15, g = lane >> 4;
    const int cmap = DIFF ? (wid >> 2) : 0, rg = DIFF ? (wid & 3) : wid;
    const int R0 = (DIFF ? 128 : 256) * qb;
    const int chunk_w = __builtin_amdgcn_readfirstlane((DIFF ? 2 * qb : 4 * qb) + (rg >> 1)), NT = (DIFF ? 2 * qb : 4 * qb) + (DIFF ? 2 : 4);
    char* V_lds = lds + AL_V; char* K_lds = lds + AL_K; float* tbl = (float*)(lds + AL_TBL);
    const bf16* Kg = (DIFF ? F.DK + (size_t)h * S * 128 : F.KM + (size_t)h * S * 192);
    const bf16* Vg = (DIFF ? F.DV : F.VM) + (size_t)h * S * 128;
    if (DIFF) { if (tid < 255) { const int rel = tid - 191; tbl[tid] = (F.rel_bias[t5_bucket(rel) * 4 + h] - F.rel_bias[15 * 4 + h]) * LOG2E; } }
    bf16x8 qr[2][KS2];
    { const bf16* Qw = (DIFF ? F.DQ + ((size_t)h * S + R0 + 32 * rg + l16) * 128 + 64 * cmap : F.QM + ((size_t)h * S + R0 + 32 * rg + l16) * 192) + 8 * g;
#pragma unroll
      for (int rt = 0; rt < 2; ++rt)
#pragma unroll
          for (int k2 = 0; k2 < KS2; ++k2) qr[rt][k2] = *(const GAS bf16x8*)(Qw + (size_t)16 * rt * QLD + 32 * k2); }
    const int vlane = (g >> 1) * 2048 + (g & 1) * 256 + (l16 >> 2) * 64 + ((l16 >> 1) & 1) * 16 + (l16 & 1) * 8;
    const int vbE0 = (int)(uintptr_t)V_lds + vlane + 32 * (g & 1), vbO0 = (int)(uintptr_t)V_lds + vlane + 32 * (1 - (g & 1));
    const int kro = l16 * KROWB, kx = DIFF ? (l16 << 4) : (((l16 >> 1) & 7) << 4), kc0 = DIFF ? (128 * cmap + 16 * g) : (16 * g);
    const int tb0 = 191 + 4 * g - (32 * (rg & 1) + l16) - 64 * chunk_w;
    auto ksrc = [&](int i) -> unsigned { const int p = (wid * NKC + i) * 64 + lane; if (DIFF) { const int row = p >> 4, ch = (p & 15) ^ (row & 15); return (unsigned)(row * 256 + ch * 16); } else { const int row = p / 24, ch = (p % 24) ^ ((row >> 1) & 7); return (unsigned)(row * 384 + ch * 16); } };
    auto vsrc = [&](int i) -> unsigned { const int p = (wid * 2 + i) * 64 + lane, sub = p >> 5, r = (p & 31) >> 2, key = (sub >> 2) * 8 + r, col = (sub & 3) * 32 + ((p & 3) ^ ((r >> 2) << 1)) * 8; return (unsigned)(key * 256 + col * 2); };
    const unsigned lds_k0 = (unsigned)(uintptr_t)K_lds + (unsigned)(wid * NKC) * 1024u, lds_v0 = (unsigned)(uintptr_t)V_lds + (unsigned)(wid * 2) * 1024u;
#ifndef ABL
#define ABL 0
#endif
#define DMA(t, sl) do { if (ABL & 1) break; const char* kt_ = (const char*)Kg + (size_t)(t) * KTILE; const char* vt_ = (const char*)Vg + (size_t)(t) * 16384; \
        _Pragma("unroll") for (int i_ = 0; i_ < NKC; ++i_) glds16(kt_ + ksrc(i_), (unsigned)__builtin_amdgcn_readfirstlane(lds_k0 + (unsigned)(sl) * KBUF + i_ * 1024)); \
        _Pragma("unroll") for (int i_ = 0; i_ < 2; ++i_) glds16(vt_ + vsrc(i_), (unsigned)__builtin_amdgcn_readfirstlane(lds_v0 + (unsigned)(sl) * VBUF + i_ * 1024)); } while (0)
#define DMA1(t, sl, pc) do { if (ABL & 1) break; if ((pc) < NKC) glds16((const char*)Kg + (size_t)(t) * KTILE + ksrc(pc), (unsigned)__builtin_amdgcn_readfirstlane(lds_k0 + (unsigned)(sl) * KBUF + (pc) * 1024)); \
        else glds16((const char*)Vg + (size_t)(t) * 16384 + vsrc((pc) - NKC), (unsigned)__builtin_amdgcn_readfirstlane(lds_v0 + (unsigned)(sl) * VBUF + ((pc) - NKC) * 1024)); } while (0)
#define KFRAG(kb, kt, k2) (*(const bf16x8*)((kb) + (kt) * 16 * KROWB + ((kc0 + 64 * (k2)) ^ kx)))
#define KPREF(kb) do { kf[0] = KFRAG(kb, 0, 0); kf[1] = KFRAG(kb, 1, 0); kf[2] = KFRAG(kb, 0, 1); kf[3] = KFRAG(kb, 1, 1); } while (0)
#define POSTQK_H(P, t, HF) do { if ((t) > chunk_w) { _Pragma("unroll") for (int r = 0; r < 16; ++r) P[r] = -1e30f; } \
        else if (DIFF && (t) + 2 >= chunk_w) { const float* tb_ = tbl + (tb0 + 64 * (t) + 32 * (HF)); \
            _Pragma("unroll") for (int r = 0; r < 16; ++r) P[r] += tb_[16 * ((r >> 2) & 1) + (r & 3) - 16 * (r >> 3)]; } } while (0)
#define VR1(i, dt, HF, vE, vO) do { vl[i] = tr_read<v_off16(dt, HF, 0)>(((dt) & 1) ? (vO) : (vE)); vh[i] = tr_read<v_off16(dt, HF, 1)>(((dt) & 1) ? (vO) : (vE)); } while (0)
#define VRDG(HF, vE, vO, q) do { if (DIFF) { VR1(2 * (q), 2 * (q), HF, vE, vO); VR1(2 * (q) + 1, 2 * (q) + 1, HF, vE, vO); } else { VR1(q, q, HF, vE, vO); } } while (0)
#define VRD(HF, vE, vO) do { VRDG(HF, vE, vO, 0); VRDG(HF, vE, vO, 1); VRDG(HF, vE, vO, 2); VRDG(HF, vE, vO, 3); } while (0)
#define SUMPK4(Pp, e) do { pw[(e) / 2] = cvtpk_s(Pp[e], Pp[(e) + 1]); pw[(e) / 2 + 1] = cvtpk_s(Pp[(e) + 2], Pp[(e) + 3]); asm volatile("" : "+v"(pw[(e) / 2]), "+v"(pw[(e) / 2 + 1])); } while (0)
#define SUMPK2(Pp, e) do { pw[(e) / 2] = cvtpk_s(Pp[e], Pp[(e) + 1]); asm volatile("" : "+v"(pw[(e) / 2])); } while (0)
#define PHASE_A(Pc, Pp, kb, HAVE_PREV, VHF, vE, vO, DODMA) do { \
        _Pragma("unroll") for (int i_ = 0; i_ < KS2; ++i_) { \
            if (i_ == 0) { mma16z<0>(Pc, kf[0], qr[0][0]); mma16z<4>(Pc, kf[1], qr[0][0]); } else { mma16<0>(Pc, kf[2 * (i_ & 1)], qr[0][i_]); mma16<4>(Pc, kf[2 * (i_ & 1) + 1], qr[0][i_]); } \
            if (!DIFF && (DODMA) && i_ < NKC + 2) DMA1(t + 2, sk_w, i_); \
            if (HAVE_PREV) { if (DIFF) SUMPK4(Pp, 8 * i_); else if (i_ < 4) SUMPK2(Pp, 4 * i_); \
                if (i_ == 0) VRDG(VHF, vE, vO, 0); if (i_ == 1) VRDG(VHF, vE, vO, 2); } \
            SBAR(); \
            if (i_ == 0) { mma16z<8>(Pc, kf[0], qr[1][0]); mma16z<12>(Pc, kf[1], qr[1][0]); } else { mma16<8>(Pc, kf[2 * (i_ & 1)], qr[1][i_]); mma16<12>(Pc, kf[2 * (i_ & 1) + 1], qr[1][i_]); } \
            if (i_ + 2 < KS2) { kf[2 * (i_ & 1)] = KFRAG(kb, 0, i_ + 2); kf[2 * (i_ & 1) + 1] = KFRAG(kb, 1, i_ + 2); } \
            if (HAVE_PREV) { if (DIFF) SUMPK4(Pp, 8 * i_ + 4); else if (i_ < 4) SUMPK2(Pp, 4 * i_ + 2); \
                if (i_ == 0) VRDG(VHF, vE, vO, 1); if (i_ == 1) VRDG(VHF, vE, vO, 3); } \
            SBAR(); } } while (0)
#define PAV(k) __builtin_bit_cast(bf16x8, (v4u){pw[4 * (k)], pw[4 * (k) + 1], pw[4 * (k) + 2], pw[4 * (k) + 3]})
#define VFR(i) (bf16x8){vl[i][0], vl[i][1], vl[i][2], vl[i][3], vh[i][0], vh[i][1], vh[i][2], vh[i][3]}
#define PVP(dt, VI, Pc, DOEXP) do { mma16<8 * ((dt) & 1)>(o[(dt) >> 1], VFR(VI), PAV(0)); mma16<8 * ((dt) & 1) + 4>(o[(dt) >> 1], VFR(VI), PAV(1)); \
        if (DOEXP) { Pc[2 * (dt)] = __builtin_amdgcn_exp2f(Pc[2 * (dt)]); Pc[2 * (dt) + 1] = __builtin_amdgcn_exp2f(Pc[2 * (dt) + 1]); asm volatile("" : "+v"(Pc[2 * (dt)]), "+v"(Pc[2 * (dt) + 1])); } SBAR(); } while (0)
#define PHASE_B(Pc, HF, vE, vO, DOEXP, kbnext, DOPREF, BDMA) do { \
        if (DIFF) { PVP(0, 0, Pc, DOEXP); if ((BDMA) && dma_) DMA1(t + 2, sk_w, 0); PVP(1, 1, Pc, DOEXP); PVP(2, 2, Pc, DOEXP); if ((BDMA) && dma_) DMA1(t + 2, sk_w, 1); PVP(3, 3, Pc, DOEXP); \
            if (DOPREF) kf[0] = KFRAG(kbnext, 0, 0); PVP(4, 4, Pc, DOEXP); if ((BDMA) && dma_) DMA1(t + 2, sk_w, 2); if (DOPREF) kf[1] = KFRAG(kbnext, 1, 0); PVP(5, 5, Pc, DOEXP); if (DOPREF) kf[2] = KFRAG(kbnext, 0, 1); PVP(6, 6, Pc, DOEXP); if ((BDMA) && dma_) DMA1(t + 2, sk_w, 3); if (DOPREF) kf[3] = KFRAG(kbnext, 1, 1); PVP(7, 7, Pc, DOEXP); } \
        else { PVP(0, 0, Pc, DOEXP); PVP(1, 1, Pc, DOEXP); VR1(0, 4, HF, vE, vO); VR1(1, 5, HF, vE, vO); SBAR(); \
            PVP(2, 2, Pc, DOEXP); PVP(3, 3, Pc, DOEXP); VR1(2, 6, HF, vE, vO); VR1(3, 7, HF, vE, vO); SBAR(); \
            if (DOPREF) { KPREF(kbnext); SBAR(); } \
            PVP(4, 0, Pc, DOEXP); PVP(5, 1, Pc, DOEXP); PVP(6, 2, Pc, DOEXP); PVP(7, 3, Pc, DOEXP); } \
        ls0 = __builtin_amdgcn_mfma_f32_16x16x32_bf16(ones, PAV(0), ls0, 0, 0, 0); ls1 = __builtin_amdgcn_mfma_f32_16x16x32_bf16(ones, PAV(1), ls1, 0, 0, 0); SBAR(); } while (0)
    const bf16x8 ones = {16256, 16256, 16256, 16256, 16256, 16256, 16256, 16256}; f32x4 ls0 = {0.f, 0.f, 0.f, 0.f}, ls1 = {0.f, 0.f, 0.f, 0.f};
    f32x16 o[4] = {}; f32x16 Pa, Pb; unsigned pw[8]; s16x4 vl[8], vh[8]; bf16x8 kf[4];
    __syncthreads();
    DMA(0, 0); DMA(1, 1); if (2 < NT) DMA(2, 2);
    asm volatile("s_waitcnt vmcnt(0)" ::: "memory"); __syncthreads();
    { const char* kb_ = K_lds + kro; KPREF(kb_); { const int t = 0, sk_w = 0; PHASE_A(Pa, Pa, kb_, false, 0, vbE0, vbO0, false); } POSTQK_H(Pa, 0, 0);
#pragma unroll
      for (int r = 0; r < 16; ++r) Pa[r] = __builtin_amdgcn_exp2f(Pa[r]);
      KPREF(kb_ + 32 * KROWB); }
    int sk_c = 0, sk_n = 1, sk_w = 2;
#define ITER(SPECIAL) do { \
        const bool dma_ = (t >= 1 && t + 2 < NT); \
        const char* kb1 = K_lds + sk_c * KBUF + 32 * KROWB + kro; const char* kbn = K_lds + sk_n * KBUF + kro; const int vE = vbE0 + sk_c * VBUF, vO = vbO0 + sk_c * VBUF; \
        PHASE_A(Pb, Pa, kb1, true, 0, vE, vO, dma_); if (SPECIAL) POSTQK_H(Pb, t, 1); \
        if (t + 1 < NT) { \
            PHASE_B(Pb, 0, vE, vO, true, kbn, true, true); \
            PHASE_A(Pa, Pb, kbn, true, 1, vE, vO, false); if (SPECIAL) POSTQK_H(Pa, t + 1, 0); PHASE_B(Pa, 1, vE, vO, true, kbn + 32 * KROWB, true, false); \
        } else { \
            PHASE_B(Pb, 0, vE, vO, true, kbn, false, false); \
            VRD(1, vE, vO); \
            { _Pragma("unroll") for (int i_ = 0; i_ < 4; ++i_) { pw[i_] = cvtpk_s(Pb[2 * i_], Pb[2 * i_ + 1]); pw[4 + i_] = cvtpk_s(Pb[8 + 2 * i_], Pb[8 + 2 * i_ + 1]); } } \
            PHASE_B(Pb, 1, vE, vO, false, kbn, false, false); \
        } \
        asm volatile("s_waitcnt vmcnt(0)" ::: "memory"); __syncthreads(); \
        { const int tmp = sk_c; sk_c = sk_n; sk_n = sk_w; sk_w = tmp; } } while (0)
    int t = 0;
    for (; t + 5 < NT; ++t) ITER(false);
    unsigned tk = 0u; int nenc = -1;
    for (; t < NT; ++t) {
        if (wid == 0) { if (t == NT - 2) { if (lane == 0) tk = __hip_atomic_fetch_add(F.ctl + CW_QUEUE, 1u, __ATOMIC_RELAXED, __HIP_MEMORY_SCOPE_AGENT); }
                        else if (t == NT - 1) { if (lane == 0) nenc = tk < 768u ? (int)((const GAS unsigned short*)(F.MODF + 4096))[tk] : -1; } }
        ITER(true); }
    if (wid == 0 && lane == 0) *(volatile int*)(lds + AL_TICKET) = nenc;
#undef ITER
#undef KFRAG
#undef KPREF
#undef PHASE_A
#undef PHASE_B
#undef PAV
#undef VFR
#undef PVP
#undef VR1
#undef VRDG
#undef SUMPK4
#undef SUMPK2
    int lane2 = lane; asm volatile("" : "+v"(lane2));
    const int ch = lane2 & 15; const bool writer = !DIFF || cmap == 0; const int colbase = DIFF ? h * 128 : 512 + h * 128;
    v4u sgv[8]; f32x4 gs0 = {1.f, 1.f, 1.f, 1.f}, gs1 = {1.f, 1.f, 1.f, 1.f}; float lam = 0.f;
    if (writer) {
#pragma unroll
        for (int i = 0; i < 8; ++i) sgv[i] = *(const GAS v4u*)(F.SG + (size_t)(R0 + 32 * rg + 4 * i + (lane2 >> 4)) * DM + colbase + 8 * ch);
        if (DIFF) { gs0 = *(const GAS f32x4*)(F.dsub + 8 * ch); gs1 = *(const GAS f32x4*)(F.dsub + 8 * ch + 4); }
    } else lam = F.MODF[3072];
    const float rl0 = __builtin_amdgcn_rcpf(ls0[0]), rl1 = __builtin_amdgcn_rcpf(ls1[0]);
    __syncthreads();
    char* stg = lds + AL_STG + wid * 8192;
    const int l16b = lane2 & 15, gb = lane2 >> 4;
#define STG_PUT(D, q, v0, v1, v2, v3) do { const int dt_ = 2 * (D) + ((q) >> 1), rt_ = (q) & 1; u32x2 w_; w_.x = cvtpk(v0, v1); w_.y = cvtpk(v2, v3); \
        *(u32x2*)(stg + (16 * rt_ + l16b) * 256 + (((2 * dt_ + (gb >> 1)) ^ l16b) << 4) + 8 * (gb & 1)) = w_; } while (0)
    if (DIFF) {
        f32x4* X4 = (f32x4*)(lds + AL_X) + rg * 1024 + lane;
        if (cmap == 1) {
#pragma unroll
            for (int D = 0; D < 4; ++D)
#pragma unroll
                for (int q = 0; q < 4; ++q) { const float rl = lam * ((q & 1) ? rl1 : rl0); X4[(D * 4 + q) * 64] = (f32x4){o[D][4 * q] * rl, o[D][4 * q + 1] * rl, o[D][4 * q + 2] * rl, o[D][4 * q + 3] * rl}; }
        }
        __syncthreads();
        if (cmap == 0) {
#pragma unroll
            for (int D = 0; D < 4; ++D)
#pragma unroll
                for (int q = 0; q < 4; ++q) { const f32x4 x = X4[(D * 4 + q) * 64]; const float rl = (q & 1) ? rl1 : rl0;
                    STG_PUT(D, q, o[D][4 * q] * rl - x[0], o[D][4 * q + 1] * rl - x[1], o[D][4 * q + 2] * rl - x[2], o[D][4 * q + 3] * rl - x[3]); }
        }
    } else {
#pragma unroll
        for (int D = 0; D < 4; ++D)
#pragma unroll
            for (int q = 0; q < 4; ++q) { const float rl = (q & 1) ? rl1 : rl0; STG_PUT(D, q, o[D][4 * q] * rl, o[D][4 * q + 1] * rl, o[D][4 * q + 2] * rl, o[D][4 * q + 3] * rl); }
    }
#undef STG_PUT
    if (writer) {
        asm volatile("s_waitcnt lgkmcnt(0)" ::: "memory");
        v4u vst[8];
#pragma unroll
        for (int i = 0; i < 8; ++i) { const int row = 4 * i + (lane2 >> 4); vst[i] = *(const LAS v4u*)(unsigned)(uintptr_t)(stg + row * 256 + ((ch ^ (row & 15)) << 4)); }
        asm volatile("s_waitcnt lgkmcnt(0)" ::: "memory");
#pragma unroll
        for (int i = 0; i < 8; ++i) { const int row = 4 * i + (lane2 >> 4); const size_t off = (size_t)(R0 + 32 * rg + row) * DM + colbase + 8 * ch;
            const v4u v = vst[i]; const v4u g = sgv[i];
            float f[8] = {__uint_as_float(v.x << 16), __uint_as_float(v.x & 0xffff0000u), __uint_as_float(v.y << 16), __uint_as_float(v.y & 0xffff0000u),
                          __uint_as_float(v.z << 16), __uint_as_float(v.z & 0xffff0000u), __uint_as_float(v.w << 16), __uint_as_float(v.w & 0xffff0000u)};
            if (DIFF) {
                float ss = (f[0] * f[0] + f[1] * f[1]) + (f[2] * f[2] + f[3] * f[3]) + (f[4] * f[4] + f[5] * f[5]) + (f[6] * f[6] + f[7] * f[7]);
                ss += __int_as_float(__builtin_amdgcn_update_dpp(0, __float_as_int(ss), 0xB1, 0xF, 0xF, true));
                ss += __int_as_float(__builtin_amdgcn_update_dpp(0, __float_as_int(ss), 0x4E, 0xF, 0xF, true));
                ss += __int_as_float(__builtin_amdgcn_update_dpp(0, __float_as_int(ss), 0x141, 0xF, 0xF, true));
                ss += __int_as_float(__builtin_amdgcn_update_dpp(0, __float_as_int(ss), 0x140, 0xF, 0xF, true));
                const float rs = rsqrtf(ss * (1.f / 128.f) + RMS_EPS) * 0.8f;
                f[0] *= rs * gs0.x; f[1] *= rs * gs0.y; f[2] *= rs * gs0.z; f[3] *= rs * gs0.w; f[4] *= rs * gs1.x; f[5] *= rs * gs1.y; f[6] *= rs * gs1.z; f[7] *= rs * gs1.w; }
            v4u w;
            w.x = cvtpk(f[0] * __uint_as_float(g.x << 16), f[1] * __uint_as_float(g.x & 0xffff0000u));
            w.y = cvtpk(f[2] * __uint_as_float(g.y << 16), f[3] * __uint_as_float(g.y & 0xffff0000u));
            w.z = cvtpk(f[4] * __uint_as_float(g.z << 16), f[5] * __uint_as_float(g.z & 0xffff0000u));
            w.w = cvtpk(f[6] * __uint_as_float(g.w << 16), f[7] * __uint_as_float(g.w & 0xffff0000u));
            *(GAS v4u*)(F.A3 + off) = w; }
    }
#ifdef FUSE_P3
    asm volatile("s_waitcnt vmcnt(0)" ::: "memory"); __syncthreads();
    if (wid == 0 && lane2 == 0) { __builtin_amdgcn_fence(__ATOMIC_RELEASE, "agent"); asm volatile("s_waitcnt vmcnt(0)" ::: "memory");
        __hip_atomic_fetch_add(F.ctl + CW_DONE + 16 * (DIFF ? (qb >> 1) : qb), 1u, __ATOMIC_RELAXED, __HIP_MEMORY_SCOPE_AGENT); }
#endif
#undef DMA
#undef DMA1
#undef VRD
#undef POSTQK_H
}
#ifndef ATT_ONLY
#define ATT_ONLY 3
#endif
__device__ __forceinline__ void attn_phase(Frame& F) {
    char* lds = (char*)F.lds; volatile int* bc = (volatile int*)(lds + AL_TICKET) - 1;
    const unsigned short* ord = (const unsigned short*)(F.MODF + 4096);
    __syncthreads();
    if (F.wave == 0 && __builtin_amdgcn_mbcnt_hi(~0u, __builtin_amdgcn_mbcnt_lo(~0u, 0u)) == 0u) {
        const unsigned idx = __hip_atomic_fetch_add(F.ctl + CW_QUEUE, 1u, __ATOMIC_RELAXED, __HIP_MEMORY_SCOPE_AGENT);
        bc[1] = idx < 768u ? (int)ord[idx] : -1; }
    __syncthreads();
    for (;;) {
        const int enc = bc[1];
        if (enc < 0) break;
#if TS_SEL == 14
        const unsigned long long tu0_ = __builtin_amdgcn_s_memrealtime();
#endif
        if (enc & 0x8000) { if (ATT_ONLY & 1) attn_unit<true>(F, (enc >> 8) & 3, enc & 255, lds); } else { if (ATT_ONLY & 2) attn_unit<false>(F, (enc >> 8) & 3, enc & 255, lds); }
#if TS_SEL == 14
        if (enc == TS_ENC && F.wave == 0 && __builtin_amdgcn_mbcnt_hi(~0u, __builtin_amdgcn_mbcnt_lo(~0u, 0u)) == 0u) { asm volatile("s_waitcnt vmcnt(0)" ::: "memory"); __hip_atomic_store((unsigned*)(F.ctl + 20200), (unsigned)(__builtin_amdgcn_s_memrealtime() - tu0_), __ATOMIC_RELAXED, __HIP_MEMORY_SCOPE_AGENT); }
#endif
    }
    __syncthreads();
}
#undef SBAR
}
__global__ void __launch_bounds__(512, 2) mk_fwd(mk::Args args) {
    using namespace mk;
    extern __shared__ __attribute__((aligned(16))) unsigned char lds[];
    Frame F;
    F.lds = (LAS unsigned char*)lds; F.MISC = (volatile LAS unsigned*)(F.lds + MISC_OFF);
    F.tid = threadIdx.x; F.lane = F.tid & 63; F.wave = __builtin_amdgcn_readfirstlane(F.tid >> 6);
    F.G = gridDim.x; { const int bx = blockIdx.x; F.vcu = (F.G % 8 == 0) ? (bx % 8) * (F.G / 8) + bx / 8 : bx; }
    unsigned char* ws = args.ws; F.ws = ws; F.ctl = (gu32*)(ws + WS_CTL);
    F.x = (const float*)args.in[0]; F.c = (const float*)args.in[1]; F.pos = (const int*)args.in[2]; F.rel_bias = (const float*)args.in[3];
    F.ada_w = (const float*)args.in[4]; F.ada_b = (const float*)args.in[5]; F.norm_g = (const float*)args.in[6]; F.w_in = (const float*)args.in[7];
    F.dqn = (const float*)args.in[8]; F.dkn = (const float*)args.in[9]; F.dlam = (const float*)args.in[10]; F.dsub = (const float*)args.in[11];
    F.qan = (const float*)args.in[12]; F.kvan = (const float*)args.in[13]; F.w_uq = (const float*)args.in[14]; F.w_uk = (const float*)args.in[15];
    F.w_uv = (const float*)args.in[16]; F.mqn = (const float*)args.in[17]; F.mkn = (const float*)args.in[18]; F.w_out = (const float*)args.in[19];
    F.out = args.out;
    F.MODP = (float*)(ws + WS_MODP); F.MODF = (float*)(ws + WS_MODF); F.ROPE = (float*)(ws + WS_ROPE); F.CQ = (bf16*)(ws + WS_CQ); F.CKV = (bf16*)(ws + WS_CKV); F.KR = (bf16*)(ws + WS_KR);
    F.BT1 = (bf16*)(ws + WS_BT1); F.BT3 = (bf16*)(ws + WS_BT3); F.WUQT = (bf16*)(ws + WS_WUQT); F.WUKT = (bf16*)(ws + WS_WUKT); F.WUVT = (bf16*)(ws + WS_WUVT);
    F.XN = (bf16*)(ws + WS_XN); F.A3 = (bf16*)(ws + WS_XN); F.DQ = (bf16*)(ws + WS_DQ); F.DK = (bf16*)(ws + WS_DK); F.DV = (bf16*)(ws + WS_DV); F.SG = (bf16*)(ws + WS_SG);
    F.QM = (bf16*)(ws + WS_QM); F.KM = (bf16*)(ws + WS_KM); F.VM = (bf16*)(ws + WS_VM);
    for (int u = F.tid; u < (LDS_BYTES - LDSCTL_OFF) / 4; u += NWAVES * 64) ((LAS unsigned*)(F.lds + LDSCTL_OFF))[u] = 0u;
    __syncthreads();
    XcdBarrier bar = xcd_barrier_post((unsigned*)(F.ctl + CW_BAR) + args.li * XCD_BAR_WORDS, F.MISC + 8); bar.wave = F.wave;
    const int lo = args.ph_lo, hi = args.ph_hi;
#ifndef TS_SEL
#define TS_SEL 0
#endif
#ifndef TS_A
#define TS_A 0
#define TS_B 1
#endif
#ifndef TS_WHAT
#define TS_WHAT 0
#endif
#ifndef TS_SCALE
#define TS_SCALE 1.0f
#endif
    unsigned long long ts_[7]; int nts_ = 0;
#if TS_SEL == 12
    unsigned long long cy_[7];
#define STAMP() do { ts_[nts_] = __builtin_amdgcn_s_memrealtime(); cy_[nts_] = __builtin_amdgcn_s_memtime(); ++nts_; } while (0)
#else
#define STAMP() do { if (TS_SEL) { ts_[nts_] = __builtin_amdgcn_s_memrealtime(); } ++nts_; } while (0)
#endif
    STAMP();
#define IN(k) (lo <= (k) && (k) < hi)
#ifndef PH_MASK
#define PH_MASK 63
#endif
#define PHM(k) (((PH_MASK) >> (k)) & 1)
    if (PHM(0) && IN(0)) { p0_prologue(F); p0_rope_table(F); if (IN(1)) xcd_barrier(bar); }
    STAMP();
    if (PHM(1) && IN(1)) { p0b_xn(F); if (IN(2)) xcd_barrier(bar); }
    STAMP();
    if (PHM(2) && IN(2)) {
        pg8::Gemm g{F.XN, F.BT1, S, NINP, DM}; pg8::StaticOrder So; So.init(S, NINP, F.G, (int)blockIdx.x);
        Epi1 E{F.DQ, F.DK, F.DV, F.SG, F.CQ, F.CKV, F.KR, F.dqn, F.dkn};
        pg8::gemm_phase<Epi1, pg8::StaticOrder, true, true>(F.lds, g, So, E, F.wave);
        if (IN(3)) { p1b_prefetch(F); xcd_barrier(bar); }
    }
    STAMP();
    if (PHM(3) && IN(3)) { p1b_phase(F); if (IN(4)) xcd_barrier(bar); }
    STAMP();
#ifdef SYNTH
    if (PHM(4) && IN(4)) {
        f32x16 acc_ = {}; bf16x8 a_ = {1, 2, 3, 4, 5, 6, 7, 8}, b_ = {8, 7, 6, 5, 4, 3, 2, 1}; float v_[8];
#pragma unroll
        for (int q = 0; q < 8; ++q) v_[q] = (float)(F.lane + q);
        for (int it = 0; it < 10000; ++it) {
            acc_ = __builtin_amdgcn_mfma_f32_32x32x16_bf16(a_, b_, acc_, 0, 0, 0);
#pragma unroll
            for (int q = 0; q < SYNTH_N; ++q) { if (SYNTH_K == 0) asm volatile("v_add_f32 %0, %0, %1" : "+v"(v_[q & 7]) : "v"(1.0f)); else asm volatile("v_exp_f32 %0, %0" : "+v"(v_[q & 7])); }
            __builtin_amdgcn_sched_barrier(0);
        }
        float sink_ = acc_[0]; for (int q = 0; q < 8; ++q) sink_ += v_[q];
        if (sink_ == 123.456f) F.MODF[3073] = sink_;
        __syncthreads();
#else
    if (PHM(4) && IN(4)) { attn_phase(F);
#endif
#if TS_SEL == 9
        if (F.wave == 0 && __builtin_amdgcn_mbcnt_hi(~0u, __builtin_amdgcn_mbcnt_lo(~0u, 0u)) == 0u) { const unsigned tnow = (unsigned)(__builtin_amdgcn_s_memrealtime() - ts_[0]); atomicMax((unsigned*)(F.ctl + 20000), 0x40000000u - tnow); atomicMax((unsigned*)(F.ctl + 20064), tnow + 1u); __hip_atomic_fetch_add((unsigned*)(F.ctl + 20128), tnow / 256u, __ATOMIC_RELAXED, __HIP_MEMORY_SCOPE_AGENT); }
#endif
#ifndef FUSE_P3
        if (IN(5)) xcd_barrier(bar);
#endif
    }
    STAMP();
    if (PHM(5) && IN(5)) {
        pg8::Gemm g{F.A3, F.BT3, S, DM, DM}; Epi3 E{F.x, F.out, F.MODF + 2048};
#ifdef FUSE_P3
        volatile int* tq = (volatile int*)(F.lds + 131072 + 16);
        for (;;) {
            __syncthreads();
            if (F.wave == 0 && __builtin_amdgcn_mbcnt_hi(~0u, __builtin_amdgcn_mbcnt_lo(~0u, 0u)) == 0u) {
                const unsigned idx = __hip_atomic_fetch_add(F.ctl + CW_P3Q, 1u, __ATOMIC_RELAXED, __HIP_MEMORY_SCOPE_AGENT);
                if (idx < 256u) { unsigned* dn = (unsigned*)(F.ctl + CW_DONE + 16 * (63 - (int)(idx >> 2)));
                    XB_SPIN(xb_ld(dn) < 12u, bar.bar);
                    __builtin_amdgcn_fence(__ATOMIC_ACQUIRE, "agent"); asm volatile("s_waitcnt vmcnt(0)" ::: "memory"); }
                tq[0] = idx < 256u ? (int)idx : -1; }
            __syncthreads();
            const int ti = tq[0];
            if (ti < 0) break;
            pg8::FixedOrder So{63 - (ti >> 2), ti & 3};
            pg8::gemm_phase<Epi3, pg8::FixedOrder, true, true>(F.lds, g, So, E, F.wave);
        }
#else
        pg8::StaticOrder So; So.init(S, DM, F.G, (int)blockIdx.x);
        pg8::gemm_phase<Epi3, pg8::StaticOrder, true, true>(F.lds, g, So, E, F.wave);
#endif
    }
    STAMP();
    if (TS_SEL) { asm volatile("s_waitcnt vmcnt(0)" ::: "memory"); __syncthreads();
        if (blockIdx.x == 0 && F.wave == 0 && __builtin_amdgcn_mbcnt_hi(~0u, __builtin_amdgcn_mbcnt_lo(~0u, 0u)) == 0u) { const int a_ = (TS_SEL == 1) ? 0 : (TS_SEL > 5 ? 0 : TS_SEL), b_ = (TS_SEL > 5 ? 1 : TS_SEL + 1); float T_ = (float)(ts_[b_] - ts_[a_]) * 0.01f;
#if TS_SEL == 12
            T_ = (float)(cy_[TS_B] - cy_[TS_A]) / (float)(ts_[TS_B] - ts_[TS_A]) * 10.0f;
#endif
#if TS_SEL == 14
            T_ = (float)__hip_atomic_load((unsigned*)(F.ctl + 20200), __ATOMIC_RELAXED, __HIP_MEMORY_SCOPE_AGENT) * 0.01f;
#endif
#if TS_SEL == 13
            T_ = (float)(ts_[TS_B] - ts_[TS_A]) * 0.01f;
#endif
#if TS_SEL == 10
            { volatile LAS unsigned long long* st_ = (volatile LAS unsigned long long*)(F.lds + MISC_OFF + 64); T_ = (float)(st_[TS_B] - st_[TS_A]) * 0.01f; }
#endif
#if TS_SEL == 9
            { const unsigned mn = 0x40000000u - __hip_atomic_load((unsigned*)(F.ctl + 20000), __ATOMIC_RELAXED, __HIP_MEMORY_SCOPE_AGENT), mx = __hip_atomic_load((unsigned*)(F.ctl + 20064), __ATOMIC_RELAXED, __HIP_MEMORY_SCOPE_AGENT), sm = __hip_atomic_load((unsigned*)(F.ctl + 20128), __ATOMIC_RELAXED, __HIP_MEMORY_SCOPE_AGENT);
              T_ = (TS_WHAT == 0) ? (float)(mx - mn) * 0.01f : (TS_WHAT == 1 ? ((float)mx - (float)sm) * 0.01f : ((float)sm - (float)mn) * 0.01f); }
#endif
#ifdef TS_OFF
            T_ = T_ > TS_OFF ? T_ - TS_OFF : 0.f;
#endif
#ifdef TS_QUANT
            T_ = TS_QUANT * floorf(T_ / TS_QUANT + 0.5f);
#endif
            F.out[0] = F.x[0] + T_ * TS_SCALE; } }
#undef IN
}
static int mk_grid = 0;
static void mk_launch(void* const* d_in, void* d_out, void* d_ws, hipStream_t stream, int ph_lo, int ph_hi, int li) {
    using namespace mk;
    if (mk_grid == 0) {
        int dev = 0, cus = 0;
        if (hipGetDevice(&dev) != hipSuccess || hipDeviceGetAttribute(&cus, hipDeviceAttributeMultiprocessorCount, dev) != hipSuccess) { fprintf(stderr, "kernel_launch: device query failed\n"); mk_grid = -1; return; }
        if (hipFuncSetAttribute((const void*)mk_fwd, hipFuncAttributeMaxDynamicSharedMemorySize, LDS_BYTES) != hipSuccess) { fprintf(stderr, "kernel_launch: hipFuncSetAttribute failed\n"); mk_grid = -1; return; }
        int per_cu = 0; (void)hipOccupancyMaxActiveBlocksPerMultiprocessor(&per_cu, (const void*)mk_fwd, NWAVES * 64, LDS_BYTES); (void)hipGetLastError();
        if (per_cu < 1) fprintf(stderr, "kernel_launch: note: occupancy query reports %d blocks per CU\n", per_cu);
        mk_grid = cus;
    }
    if (mk_grid < 0) return;
    if (li == 0) (void)hipMemsetAsync((char*)d_ws + WS_CTL, 0, 128 * 1024, stream);
    Args a{}; for (int i = 0; i < 20; ++i) a.in[i] = d_in[i]; a.out = (float*)d_out; a.ws = (unsigned char*)d_ws;
    a.ph_lo = ph_lo; a.ph_hi = ph_hi; a.li = li; a.pad = 0;
    hipLaunchKernelGGL(mk_fwd, dim3(mk_grid), dim3(NWAVES * 64), LDS_BYTES, stream, a);
    const hipError_t le = hipPeekAtLastError();
    if (le != hipSuccess) fprintf(stderr, "kernel_launch: launch failed: %s\n", hipGetErrorName(le));
}
extern "C" void kernel_launch(void* const* d_in, const int* in_sizes, int n_in, void* d_out, int out_size, void* d_ws, size_t ws_size, hipStream_t stream) {
    mk_launch(d_in, d_out, d_ws, stream, 0, 6, 0);
}
```
